# Optimizing an MI355X kernel written in HIP

```python
import jax
import jax.numpy as jnp
from jax import lax
import numpy as np

D_MODEL = 1024
BATCH = 4
SEQ = 4096
DEPTH = 2

N_EVEN = (DEPTH + 1) // 2
N_ODD = DEPTH // 2
NORM_EPS = 1e-6

GLA_HEADS = 4
GLA_DK = 64
GLA_DV = 128
GLA_LOWRANK = 16
GLA_GATE_NORM = 16.0
GLA_CHUNK = 16
GLA_WIDTH = GLA_HEADS * GLA_DV
GLA_SPLITS = (GLA_HEADS * GLA_DK, GLA_HEADS * GLA_DK, GLA_WIDTH, GLA_WIDTH, GLA_LOWRANK)
GLA_COLS = 2 * GLA_HEADS * GLA_DK + 2 * GLA_WIDTH + GLA_LOWRANK

RWKV_HEADS = 8
RWKV_N = 64
RWKV_W_LORA = 64
RWKV_A_LORA = 64
RWKV_G_LORA = 128
RWKV_GN_EPS = 64e-5
RWKV_WIDTH = RWKV_HEADS * RWKV_N
RWKV_SPLITS = (RWKV_WIDTH, RWKV_W_LORA, RWKV_WIDTH, RWKV_WIDTH, RWKV_A_LORA, RWKV_G_LORA)
RWKV_COLS = 3 * RWKV_WIDTH + RWKV_W_LORA + RWKV_A_LORA + RWKV_G_LORA
EVEN_COLS = GLA_COLS + RWKV_COLS
EVEN_MIX_WIDTH = GLA_WIDTH + RWKV_WIDTH

NSA_HEADS = 16
NSA_GROUPS = 4
NSA_REP = NSA_HEADS // NSA_GROUPS
NSA_DH = 64
NSA_WIDTH = NSA_HEADS * NSA_DH
NSA_KV = NSA_GROUPS * NSA_DH
NSA_CMP_LEN = 32
NSA_CMP_STRIDE = 16
NSA_CMP_HIDDEN = 64
NSA_SEL_LEN = 64
NSA_N_SEL = 8
NSA_N_LOCAL = 2
NSA_WINDOW = 512
NSA_Q_BLOCK = 128
NSA_FORCE = 100.0
ODD_SPLITS = (NSA_WIDTH, NSA_KV, NSA_KV, NSA_KV, NSA_KV, NSA_KV, NSA_KV, 3 * NSA_HEADS)
ODD_COLS = NSA_WIDTH + 6 * NSA_KV + 3 * NSA_HEADS

FFN_HIDDEN = 2816
CONV_WIDTH = 3

kernel_name = 'hybrid_gla_rwkv7_nsa_convffn_adaln'


def _split(t, sizes):
    return jnp.split(t, np.cumsum(sizes)[:-1].tolist(), axis=-1)


def _rmsnorm(x, g, eps=NORM_EPS):
    x32 = x.astype(jnp.float32)
    y = x32 * lax.rsqrt(jnp.mean(x32 * x32, axis=-1, keepdims=True) + eps)
    return (y * g).astype(x.dtype)


def _masked_softmax(s, mask):
    s = jnp.where(mask, s, -jnp.inf)
    m = jnp.max(s, axis=-1, keepdims=True)
    m = jnp.where(jnp.isfinite(m), m, 0.0)
    e = jnp.exp(s - m)
    den = jnp.sum(e, axis=-1, keepdims=True)
    return e / jnp.where(den > 0, den, 1.0)


def _gla_chunked(q, k, v, log_a):
    B, T, H, DK = q.shape
    DV = v.shape[-1]
    C = GLA_CHUNK
    N = T // C

    def chunks(t):
        return t.astype(jnp.float32).reshape(B, N, C, H, t.shape[-1]).transpose(0, 3, 1, 2, 4)

    q, k, v, log_a = chunks(q * DK ** -0.5), chunks(k), chunks(v), chunks(log_a)
    b = jnp.cumsum(log_a, axis=3)
    causal = jnp.tril(jnp.ones((C, C), dtype=bool))
    rel = jnp.where(causal[:, :, None], b[:, :, :, :, None, :] - b[:, :, :, None, :, :], -jnp.inf)
    scores = jnp.einsum('bhntk,bhnsk,bhntsk->bhnts', q, k, jnp.exp(rel))
    o_intra = jnp.einsum('bhnts,bhnsv->bhntv', scores, v)
    b_end = b[:, :, :, -1]
    upd = jnp.einsum('bhnsk,bhnsv->bhnkv', k * jnp.exp(b_end[:, :, :, None] - b), v)

    def step(state, inp):
        decay, u = inp
        return decay[..., None] * state + u, state

    s0 = jnp.zeros((B, H, DK, DV), jnp.float32)
    _, s_prev = lax.scan(step, s0, (jnp.moveaxis(jnp.exp(b_end), 2, 0), jnp.moveaxis(upd, 2, 0)))
    s_prev = jnp.moveaxis(s_prev, 0, 2)
    o_inter = jnp.einsum('bhntk,bhnkv->bhntv', q * jnp.exp(b), s_prev)
    return (o_intra + o_inter).transpose(0, 2, 3, 1, 4).reshape(B, T, H, DV)


def _rwkv7_scan(r, w, k, v, kk, a):
    B, T, H, N = r.shape

    def step(state, inp):
        r_t, w_t, k_t, v_t, kk_t, a_t = inp
        removed = jnp.einsum('bhvk,bhk->bhv', state, kk_t)
        state = (state * w_t[:, :, None, :]
                 - removed[..., None] * (kk_t * a_t)[:, :, None, :]
                 + v_t[..., None] * k_t[:, :, None, :])
        return state, jnp.einsum('bhvk,bhk->bhv', state, r_t)

    s0 = jnp.zeros((B, H, N, N), jnp.float32)
    _, y = lax.scan(step, s0, tuple(jnp.moveaxis(t, 1, 0) for t in (r, w, k, v, kk, a)))
    return jnp.moveaxis(y, 0, 1)


def _even_mixer(h, w_in, shift_mu, a_up, a_b, gla_g, w0, w2, a0, a2, g2, k_k, k_a, r_k,
                gn_w, gn_b, w_out):
    B, T, _ = h.shape
    hd = lambda t, d: t.reshape(B, T, -1, d)
    p = (h @ w_in).astype(jnp.float32)
    p_gla, p_rw = p[..., :GLA_COLS], p[..., GLA_COLS:]
    q, k, v, og, lr = _split(p_gla, GLA_SPLITS)
    log_a = jax.nn.log_sigmoid(lr @ a_up + a_b) / GLA_GATE_NORM
    o = _gla_chunked(hd(q, GLA_DK), hd(k, GLA_DK), hd(v, GLA_DV), hd(log_a, GLA_DK))
    o_gla = (_rmsnorm(o, gla_g) * jax.nn.silu(hd(og, GLA_DV))).reshape(B, T, GLA_WIDTH)
    p_prev = jnp.concatenate([jnp.zeros_like(p_rw[:, :1]), p_rw[:, :-1]], axis=1)
    p_rw = p_rw + (p_prev - p_rw) * shift_mu
    r, wl, k, v, al, gl = _split(p_rw, RWKV_SPLITS)
    w = jnp.exp(-jnp.exp(-jax.nn.softplus(-(w0 + jnp.tanh(wl) @ w2)) - 0.5))
    a = jax.nn.sigmoid(a0 + al @ a2)
    g = jax.nn.sigmoid(gl) @ g2
    kk = hd(k * k_k, RWKV_N)
    kk = kk * lax.rsqrt(jnp.maximum(jnp.sum(kk * kk, axis=-1, keepdims=True), 1e-24))
    k = k * (1.0 + (a - 1.0) * k_a)
    rh, kh, vh = hd(r, RWKV_N), hd(k, RWKV_N), hd(v, RWKV_N)
    y = _rwkv7_scan(rh, hd(w, RWKV_N), kh, vh, kk, hd(a, RWKV_N))
    mu = jnp.mean(y, axis=-1, keepdims=True)
    var = jnp.mean(jnp.square(y - mu), axis=-1, keepdims=True)
    y = ((y - mu) * lax.rsqrt(var + RWKV_GN_EPS)).reshape(B, T, RWKV_WIDTH) * gn_w + gn_b
    bonus = (jnp.sum(rh * kh * r_k, axis=-1, keepdims=True) * vh).reshape(B, T, RWKV_WIDTH)
    o_rw = (y + bonus) * g
    out = jnp.concatenate([o_gla, o_rw], axis=-1) @ w_out
    return out.astype(h.dtype)


def _compress(t, pe, w1, w2, cmp_start):
    B, T, G, DH = t.shape
    idx = cmp_start[:, None] + jnp.arange(NSA_CMP_LEN)[None, :]
    blocks = t[:, idx] + pe[:, None, :]
    flat = blocks.transpose(0, 1, 3, 2, 4).reshape(B, idx.shape[0], G, NSA_CMP_LEN * DH)
    return jax.nn.gelu(flat @ w1) @ w2


def _nsa_mixer(h, w_in, pe_k, w1_k, w2_k, pe_v, w1_v, w2_v, w_out):
    B, T, _ = h.shape
    G, R, DH = NSA_GROUPS, NSA_REP, NSA_DH
    f32 = jnp.float32
    p = h @ w_in
    q, kc, vc, ks, vs, kw, vw, gt = _split(p, ODD_SPLITS)
    q = q.reshape(B, T, G, R, DH) * DH ** -0.5
    kc, vc, ks, vs, kw, vw = (t.reshape(B, T, G, DH) for t in (kc, vc, ks, vs, kw, vw))
    gates = jax.nn.sigmoid(gt.astype(f32)).reshape(B, T, G, R, 3)
    slopes = (2.0 ** (-8.0 * jnp.arange(1, NSA_HEADS + 1, dtype=f32) / NSA_HEADS)).reshape(G, R)
    n_cmp = (T - NSA_CMP_LEN) // NSA_CMP_STRIDE + 1
    cmp_start = jnp.arange(n_cmp) * NSA_CMP_STRIDE
    cmp_end = cmp_start + NSA_CMP_LEN - 1
    kc = _compress(kc, pe_k, w1_k, w2_k, cmp_start)
    vc = _compress(vc, pe_v, w1_v, w2_v, cmp_start)
    n_sel = T // NSA_SEL_LEN
    k_sel = min(NSA_N_SEL, n_sel)
    sel_start = jnp.arange(n_sel) * NSA_SEL_LEN
    overlap = ((cmp_start[:, None] <= sel_start[None, :] + NSA_SEL_LEN - 1)
               & (cmp_end[:, None] >= sel_start[None, :])).astype(f32)
    ks_blk = ks.reshape(B, n_sel, NSA_SEL_LEN, G, DH).transpose(0, 3, 1, 2, 4)
    vs_blk = vs.reshape(B, n_sel, NSA_SEL_LEN, G, DH).transpose(0, 3, 1, 2, 4)
    pad = ((0, 0), (NSA_WINDOW, 0), (0, 0), (0, 0))
    kw_pad, vw_pad = jnp.pad(kw, pad), jnp.pad(vw, pad)
    b_idx = jnp.arange(B)[:, None, None, None]
    g_idx = jnp.arange(G)[None, :, None, None]
    QB = NSA_Q_BLOCK

    def query_block(qi):
        q0 = qi * QB
        qb = lax.dynamic_slice_in_dim(q, q0, QB, axis=1)
        t = q0 + jnp.arange(QB)
        dist_c = t[:, None] - cmp_end[None, :]
        s = jnp.einsum('bqgrd,bngd->bgrqn', qb, kc).astype(f32) - slopes[:, :, None, None] * dist_c
        p_c = _masked_softmax(s, dist_c >= 0)
        o_c = jnp.einsum('bgrqn,bngd->bqgrd', p_c.astype(vc.dtype), vc)
        imp = jnp.einsum('bgrqn,nj->bgqj', p_c, overlap)
        blk = jnp.arange(n_sel)
        ahead = (t // NSA_SEL_LEN)[:, None] - blk[None, :]
        valid = ahead >= 0
        forced = (blk[None, :] == 0) | (valid & (ahead < NSA_N_LOCAL))
        score = jnp.where(valid, imp + jnp.where(forced, NSA_FORCE, 0.0), -NSA_FORCE)
        _, sel = lax.top_k(score, k_sel)
        tok = (sel[..., None] * NSA_SEL_LEN + jnp.arange(NSA_SEL_LEN)).reshape(B, G, QB, k_sel * NSA_SEL_LEN)
        dist_s = t[:, None] - tok
        k_g = ks_blk[b_idx, g_idx, sel].reshape(B, G, QB, k_sel * NSA_SEL_LEN, DH)
        v_g = vs_blk[b_idx, g_idx, sel].reshape(B, G, QB, k_sel * NSA_SEL_LEN, DH)
        s = (jnp.einsum('bqgrd,bgqmd->bgrqm', qb, k_g).astype(f32)
             - slopes[:, :, None, None] * dist_s[:, :, None])
        p_s = _masked_softmax(s, dist_s[:, :, None] >= 0)
        o_s = jnp.einsum('bgrqm,bgqmd->bqgrd', p_s.astype(v_g.dtype), v_g)
        k_w = lax.dynamic_slice_in_dim(kw_pad, q0, QB + NSA_WINDOW, axis=1)
        v_w = lax.dynamic_slice_in_dim(vw_pad, q0, QB + NSA_WINDOW, axis=1)
        pos = q0 - NSA_WINDOW + jnp.arange(QB + NSA_WINDOW)
        dist_w = t[:, None] - pos[None, :]
        mask_w = (dist_w >= 0) & (dist_w < NSA_WINDOW) & (pos[None, :] >= 0)
        s = jnp.einsum('bqgrd,bkgd->bgrqk', qb, k_w).astype(f32) - slopes[:, :, None, None] * dist_w
        p_w = _masked_softmax(s, mask_w)
        o_w = jnp.einsum('bgrqk,bkgd->bqgrd', p_w.astype(v_w.dtype), v_w)
        gb = lax.dynamic_slice_in_dim(gates, q0, QB, axis=1)
        return gb[..., 0:1] * o_c + gb[..., 1:2] * o_s + gb[..., 2:3] * o_w

    out = lax.map(query_block, jnp.arange(T // QB))
    out = jnp.moveaxis(out, 0, 1).reshape(B, T, NSA_WIDTH)
    return (out @ w_out).astype(h.dtype)


def _conv_ffn(h, w_up, conv_w, conv_b, w_down):
    u, v = jnp.split(h @ w_up, 2, axis=-1)
    u = lax.conv_general_dilated(u, conv_w[:, None, :].astype(u.dtype), window_strides=(1,),
                                 padding=[(CONV_WIDTH - 1, 0)],
                                 dimension_numbers=('NWC', 'WIO', 'NWC'),
                                 feature_group_count=FFN_HIDDEN) + conv_b
    return ((jax.nn.gelu(u) * v) @ w_down).astype(h.dtype)


def setup_inputs(seed: int = 0) -> dict:
    key = jax.random.key(seed)
    keys = iter(jax.random.split(key, 40))
    nrm = lambda shape, scale: jax.random.normal(next(keys), shape, jnp.float32) * scale
    uni = lambda shape, lo, hi: jax.random.uniform(next(keys), shape, jnp.float32, lo, hi)
    D, F = D_MODEL, FFN_HIDDEN
    L = NSA_CMP_LEN * NSA_DH
    return {
        'x': nrm((BATCH, SEQ, D), 1.0),
        'c': nrm((BATCH, D), 1.0),
        'ada_w': nrm((DEPTH, D, 6 * D), D ** -0.5),
        'ada_b': nrm((DEPTH, 6 * D), 0.02),
        'norm1_g': 1.0 + nrm((DEPTH, D), 0.02),
        'norm2_g': 1.0 + nrm((DEPTH, D), 0.02),
        'ffn_w_up': nrm((DEPTH, D, 2 * F), D ** -0.5),
        'ffn_conv_w': nrm((DEPTH, CONV_WIDTH, F), CONV_WIDTH ** -0.5),
        'ffn_conv_b': nrm((DEPTH, F), 0.02),
        'ffn_w_down': nrm((DEPTH, F, D), F ** -0.5),
        'ev_w_in': nrm((N_EVEN, D, EVEN_COLS), D ** -0.5),
        'ev_shift_mu': uni((N_EVEN, RWKV_COLS), 0.0, 1.0),
        'gla_a_up': nrm((N_EVEN, GLA_LOWRANK, GLA_HEADS * GLA_DK), GLA_LOWRANK ** -0.5),
        'gla_a_b': nrm((N_EVEN, GLA_HEADS * GLA_DK), 0.1),
        'gla_norm_g': 1.0 + nrm((N_EVEN, GLA_DV), 0.02),
        'rw_w0': uni((N_EVEN, RWKV_WIDTH), -5.0, 1.0),
        'rw_w2': nrm((N_EVEN, RWKV_W_LORA, RWKV_WIDTH), RWKV_W_LORA ** -0.5),
        'rw_a0': nrm((N_EVEN, RWKV_WIDTH), 0.1),
        'rw_a2': nrm((N_EVEN, RWKV_A_LORA, RWKV_WIDTH), RWKV_A_LORA ** -0.5),
        'rw_g2': nrm((N_EVEN, RWKV_G_LORA, RWKV_WIDTH), RWKV_G_LORA ** -0.5),
        'rw_k_k': 0.85 + nrm((N_EVEN, RWKV_WIDTH), 0.02),
        'rw_k_a': 1.0 + nrm((N_EVEN, RWKV_WIDTH), 0.02),
        'rw_r_k': nrm((N_EVEN, RWKV_HEADS, RWKV_N), 0.1),
        'rw_gn_w': 1.0 + nrm((N_EVEN, RWKV_WIDTH), 0.02),
        'rw_gn_b': nrm((N_EVEN, RWKV_WIDTH), 0.02),
        'ev_w_out': nrm((N_EVEN, EVEN_MIX_WIDTH, D), EVEN_MIX_WIDTH ** -0.5),
        'od_w_in': nrm((N_ODD, D, ODD_COLS), D ** -0.5),
        'cmp_pe_k': nrm((N_ODD, NSA_CMP_LEN, NSA_DH), 0.1),
        'cmp_w1_k': nrm((N_ODD, L, NSA_CMP_HIDDEN), L ** -0.5),
        'cmp_w2_k': nrm((N_ODD, NSA_CMP_HIDDEN, NSA_DH), NSA_CMP_HIDDEN ** -0.5),
        'cmp_pe_v': nrm((N_ODD, NSA_CMP_LEN, NSA_DH), 0.1),
        'cmp_w1_v': nrm((N_ODD, L, NSA_CMP_HIDDEN), L ** -0.5),
        'cmp_w2_v': nrm((N_ODD, NSA_CMP_HIDDEN, NSA_DH), NSA_CMP_HIDDEN ** -0.5),
        'od_w_out': nrm((N_ODD, NSA_WIDTH, D), NSA_WIDTH ** -0.5),
        'final_norm_g': 1.0 + nrm((D,), 0.02),
    }


def reference(x, c, ada_w, ada_b, norm1_g, norm2_g, ffn_w_up, ffn_conv_w, ffn_conv_b, ffn_w_down,
              ev_w_in, ev_shift_mu, gla_a_up, gla_a_b, gla_norm_g, rw_w0, rw_w2, rw_a0, rw_a2,
              rw_g2, rw_k_k, rw_k_a, rw_r_k, rw_gn_w, rw_gn_b, ev_w_out,
              od_w_in, cmp_pe_k, cmp_w1_k, cmp_w2_k, cmp_pe_v, cmp_w1_v, cmp_w2_v, od_w_out,
              final_norm_g):
    cond = jax.nn.silu(c)
    for layer in range(DEPTH):
        mod = cond @ ada_w[layer] + ada_b[layer]
        sh1, sc1, g1, sh2, sc2, g2 = jnp.split(mod[:, None, :], 6, axis=-1)
        hn = _rmsnorm(x, norm1_g[layer]) * (1.0 + sc1) + sh1
        i = layer // 2
        if layer % 2 == 0:
            mix = _even_mixer(hn, ev_w_in[i], ev_shift_mu[i], gla_a_up[i], gla_a_b[i], gla_norm_g[i],
                              rw_w0[i], rw_w2[i], rw_a0[i], rw_a2[i], rw_g2[i], rw_k_k[i], rw_k_a[i],
                              rw_r_k[i], rw_gn_w[i], rw_gn_b[i], ev_w_out[i])
        else:
            mix = _nsa_mixer(hn, od_w_in[i], cmp_pe_k[i], cmp_w1_k[i], cmp_w2_k[i],
                             cmp_pe_v[i], cmp_w1_v[i], cmp_w2_v[i], od_w_out[i])
        x = x + g1 * mix
        hn = _rmsnorm(x, norm2_g[layer]) * (1.0 + sc2) + sh2
        x = x + g2 * _conv_ffn(hn, ffn_w_up[layer], ffn_conv_w[layer], ffn_conv_b[layer], ffn_w_down[layer])
    return _rmsnorm(x, final_norm_g)
```

```cpp
#include <hip/hip_runtime.h>
#include <cstdio>
#include <cstdint>
#include <cmath>

namespace {
constexpr int D = 1024, NB = 4, T = 4096, DEPTH = 2, F = 2816;
constexpr int EVC = 3344, GLAC = 1552, RWC = 1792, ODC = 2608;
constexpr float EPS = 1e-6f;

__device__ __forceinline__ float sigmoidf_(float x) { return 1.f / (1.f + expf(-x)); }
__device__ __forceinline__ float siluf_(float x) { return x / (1.f + expf(-x)); }
__device__ __forceinline__ float softplusf_(float x) { return fmaxf(x, 0.f) + log1pf(expf(-fabsf(x))); }
__device__ __forceinline__ float gelu_tanh(float x) { return 0.5f * x * (1.f + tanhf(0.7978845608028654f * (x + 0.044715f * x * x * x))); }
__device__ __forceinline__ float wave_sum(float v) {
#pragma unroll
    for (int o = 32; o > 0; o >>= 1) v += __shfl_xor(v, o);
    return v;
}
__device__ __forceinline__ float wave_max(float v) {
#pragma unroll
    for (int o = 32; o > 0; o >>= 1) v = fmaxf(v, __shfl_xor(v, o));
    return v;
}

__global__ void k_mod(const float* c, const float* ada_w, const float* ada_b, float* mod) {
    const int j = blockIdx.x * 256 + threadIdx.x, b = blockIdx.y, l = blockIdx.z;
    __shared__ float sc[D];
    for (int i = threadIdx.x; i < D; i += 256) sc[i] = siluf_(c[b * D + i]);
    __syncthreads();
    const float* w = ada_w + (size_t)l * D * 6 * D + j;
    float acc = ada_b[l * 6 * D + j];
    for (int i = 0; i < D; ++i) acc += sc[i] * w[(size_t)i * 6 * D];
    mod[((size_t)l * NB + b) * 6 * D + j] = acc;
}

__global__ void k_norm(const float* x, const float* g, const float* sh, const float* sc, float* out) {
    const int row = blockIdx.x, tid = threadIdx.x;
    const float4 v = ((const float4*)(x + (size_t)row * D))[tid];
    float s = v.x * v.x + v.y * v.y + v.z * v.z + v.w * v.w;
    s = wave_sum(s);
    __shared__ float red[4];
    if ((tid & 63) == 0) red[tid >> 6] = s;
    __syncthreads();
    const float tot = red[0] + red[1] + red[2] + red[3];
    const float rstd = rsqrtf(tot * (1.f / D) + EPS);
    const float4 gg = ((const float4*)g)[tid];
    float4 o;
    o.x = v.x * rstd * gg.x; o.y = v.y * rstd * gg.y; o.z = v.z * rstd * gg.z; o.w = v.w * rstd * gg.w;
    if (sc) {
        const float4 s4 = ((const float4*)sc)[tid], h4 = ((const float4*)sh)[tid];
        o.x = o.x * (1.f + s4.x) + h4.x; o.y = o.y * (1.f + s4.y) + h4.y; o.z = o.z * (1.f + s4.z) + h4.z; o.w = o.w * (1.f + s4.w) + h4.w;
    }
    ((float4*)(out + (size_t)row * D))[tid] = o;
}

__global__ void __launch_bounds__(256) k_gemm(const float* A, int lda, const float* Bm, int ldb, float* C, int ldc, int M, int N, int K, int mode, const float* X, const float* gate) {
    __shared__ float As[16][132];
    __shared__ float Bs[16][132];
    const int tid = threadIdx.x, tx = tid & 15, ty = tid >> 4;
    const int m0 = blockIdx.y * 128, n0 = blockIdx.x * 128;
    float acc[8][8];
#pragma unroll
    for (int i = 0; i < 8; ++i)
#pragma unroll
        for (int j = 0; j < 8; ++j) acc[i][j] = 0.f;
    const int ar = tid >> 1, ak = (tid & 1) * 8;
    const int bk = tid >> 4, bn = (tid & 15) * 8;
    for (int k0 = 0; k0 < K; k0 += 16) {
        const float* ap = A + (size_t)(m0 + ar) * lda + k0 + ak;
        const float4 a0 = *(const float4*)ap, a1 = *(const float4*)(ap + 4);
        float bv[8];
#pragma unroll
        for (int j = 0; j < 8; ++j) { const int n = n0 + bn + j; bv[j] = (n < N) ? Bm[(size_t)(k0 + bk) * ldb + n] : 0.f; }
        __syncthreads();
        As[ak + 0][ar] = a0.x; As[ak + 1][ar] = a0.y; As[ak + 2][ar] = a0.z; As[ak + 3][ar] = a0.w;
        As[ak + 4][ar] = a1.x; As[ak + 5][ar] = a1.y; As[ak + 6][ar] = a1.z; As[ak + 7][ar] = a1.w;
#pragma unroll
        for (int j = 0; j < 8; ++j) Bs[bk][bn + j] = bv[j];
        __syncthreads();
#pragma unroll
        for (int kk = 0; kk < 16; ++kk) {
            float a[8], b[8];
#pragma unroll
            for (int i = 0; i < 8; ++i) a[i] = As[kk][ty * 8 + i];
#pragma unroll
            for (int j = 0; j < 8; ++j) b[j] = Bs[kk][tx * 8 + j];
#pragma unroll
            for (int i = 0; i < 8; ++i)
#pragma unroll
                for (int j = 0; j < 8; ++j) acc[i][j] += a[i] * b[j];
        }
    }
#pragma unroll
    for (int i = 0; i < 8; ++i) {
        const int m = m0 + ty * 8 + i;
#pragma unroll
        for (int j = 0; j < 8; ++j) {
            const int n = n0 + tx * 8 + j;
            if (n < N) {
                float v = acc[i][j];
                if (mode == 1) v = X[(size_t)m * ldc + n] + gate[n] * v;
                C[(size_t)m * ldc + n] = v;
            }
        }
    }
}

__global__ void k_gla_loga(const float* P0, const float* a_up, const float* a_b, float* LOGA) {
    const int t = blockIdx.x, c = threadIdx.x;
    const float* lr = P0 + (size_t)t * EVC + 1536;
    float acc = a_b[c];
    for (int j = 0; j < 16; ++j) acc += lr[j] * a_up[j * 256 + c];
    LOGA[(size_t)t * 256 + c] = -softplusf_(-acc) * (1.f / 16.f);
}
__global__ void __launch_bounds__(128) k_gla_scan(const float* P0, const float* LOGA, float* O) {
    const int h = blockIdx.x, v = threadIdx.x;
    float S[64];
#pragma unroll
    for (int k = 0; k < 64; ++k) S[k] = 0.f;
    for (int t = 0; t < T; ++t) {
        const float* row = P0 + (size_t)t * EVC;
        const float* q = row + h * 64; const float* kx = row + 256 + h * 64; const float vv = row[512 + h * 128 + v];
        const float* la = LOGA + (size_t)t * 256 + h * 64;
        float o = 0.f;
#pragma unroll
        for (int k = 0; k < 64; ++k) { S[k] = expf(la[k]) * S[k] + kx[k] * vv; o += q[k] * S[k]; }
        O[(size_t)t * 512 + h * 128 + v] = o * 0.125f;
    }
}
__global__ void __launch_bounds__(128) k_gla_out(const float* O, const float* P0, const float* gla_g, float* MIX) {
    const int t = blockIdx.x, h = blockIdx.y, v = threadIdx.x;
    const float o = O[(size_t)t * 512 + h * 128 + v];
    float s = wave_sum(o * o);
    __shared__ float red[2];
    if ((v & 63) == 0) red[v >> 6] = s;
    __syncthreads();
    const float rstd = rsqrtf((red[0] + red[1]) * (1.f / 128.f) + EPS);
    const float og = P0[(size_t)t * EVC + 1024 + h * 128 + v];
    MIX[(size_t)t * D + h * 128 + v] = o * rstd * gla_g[v] * siluf_(og);
}
__global__ void k_rw_shift(const float* P0, const float* mu, float* PRW) {
    const int t = blockIdx.x;
    for (int c = threadIdx.x; c < RWC; c += 256) {
        const float p = P0[(size_t)t * EVC + GLAC + c];
        const float pp = t > 0 ? P0[(size_t)(t - 1) * EVC + GLAC + c] : 0.f;
        PRW[(size_t)t * RWC + c] = p + (pp - p) * mu[c];
    }
}
__global__ void __launch_bounds__(512) k_rw_lora(const float* PRW, const float* w0, const float* w2, const float* a0, const float* a2, const float* g2, float* Wd, float* Aa, float* Gg) {
    const int t = blockIdx.x, c = threadIdx.x;
    __shared__ float tw[64], al[64], sg[128];
    const float* row = PRW + (size_t)t * RWC;
    if (c < 64) { tw[c] = tanhf(row[512 + c]); al[c] = row[1600 + c]; }
    if (c >= 64 && c < 192) sg[c - 64] = sigmoidf_(row[1664 + c - 64]);
    __syncthreads();
    float wa = w0[c], aa = a0[c], ga = 0.f;
#pragma unroll 4
    for (int j = 0; j < 64; ++j) { wa += tw[j] * w2[j * 512 + c]; aa += al[j] * a2[j * 512 + c]; }
#pragma unroll 4
    for (int j = 0; j < 128; ++j) ga += sg[j] * g2[j * 512 + c];
    Wd[(size_t)t * 512 + c] = expf(-expf(-softplusf_(-wa) - 0.5f));
    Aa[(size_t)t * 512 + c] = sigmoidf_(aa);
    Gg[(size_t)t * 512 + c] = ga;
}
__global__ void __launch_bounds__(64) k_rw_kk(const float* PRW, const float* Aa, const float* k_k, const float* k_a, float* KK, float* K2) {
    const int t = blockIdx.x, h = blockIdx.y, c = h * 64 + threadIdx.x;
    const float k = PRW[(size_t)t * RWC + 576 + c];
    const float kr = k * k_k[c];
    const float n2 = wave_sum(kr * kr);
    KK[(size_t)t * 512 + c] = kr * rsqrtf(fmaxf(n2, 1e-24f));
    K2[(size_t)t * 512 + c] = k * (1.f + (Aa[(size_t)t * 512 + c] - 1.f) * k_a[c]);
}
__global__ void __launch_bounds__(64) k_rw_scan(const float* PRW, const float* Wd, const float* Aa, const float* KK, const float* K2, float* Y) {
    const int h = blockIdx.x, vr = threadIdx.x;
    float S[64];
#pragma unroll
    for (int k = 0; k < 64; ++k) S[k] = 0.f;
    for (int t = 0; t < T; ++t) {
        const float* r = PRW + (size_t)t * RWC + h * 64;
        const float vv = PRW[(size_t)t * RWC + 1088 + h * 64 + vr];
        const float* w = Wd + (size_t)t * 512 + h * 64; const float* a = Aa + (size_t)t * 512 + h * 64;
        const float* kk = KK + (size_t)t * 512 + h * 64; const float* k2 = K2 + (size_t)t * 512 + h * 64;
        float rem = 0.f;
#pragma unroll
        for (int k = 0; k < 64; ++k) rem += S[k] * kk[k];
        float y = 0.f;
#pragma unroll
        for (int k = 0; k < 64; ++k) { S[k] = S[k] * w[k] - rem * (kk[k] * a[k]) + vv * k2[k]; y += S[k] * r[k]; }
        Y[(size_t)t * 512 + h * 64 + vr] = y;
    }
}
__global__ void __launch_bounds__(64) k_rw_out(const float* Y, const float* PRW, const float* K2, const float* Gg, const float* r_k, const float* gn_w, const float* gn_b, float* MIX) {
    const int t = blockIdx.x, h = blockIdx.y, i = threadIdx.x, c = h * 64 + i;
    const float y = Y[(size_t)t * 512 + c];
    const float mu = wave_sum(y) * (1.f / 64.f);
    const float dv = y - mu;
    const float var = wave_sum(dv * dv) * (1.f / 64.f);
    const float yn = dv * rsqrtf(var + 64e-5f) * gn_w[c] + gn_b[c];
    const float r = PRW[(size_t)t * RWC + c], k = K2[(size_t)t * 512 + c], v = PRW[(size_t)t * RWC + 1088 + c];
    const float bon = wave_sum(r * k * r_k[c]) * v;
    MIX[(size_t)t * D + 512 + c] = (yn + bon) * Gg[(size_t)t * 512 + c];
}

__global__ void k_conv(const float* UV, const float* cw, const float* cb, float* H) {
    const int t = blockIdx.x;
    for (int f = threadIdx.x; f < F; f += 256) {
        float u = cb[f];
#pragma unroll
        for (int j = 0; j < 3; ++j) { const int tt = t - 2 + j; if (tt >= 0) u += cw[j * F + f] * UV[(size_t)tt * 2 * F + f]; }
        H[(size_t)t * F + f] = gelu_tanh(u) * UV[(size_t)t * 2 * F + F + f];
    }
}

__global__ void __launch_bounds__(64) k_cmp_hidden(const float* P1, int off, const float* pe, const float* w1, float* HID) {
    const int n = blockIdx.x, g = blockIdx.y, j = threadIdx.x;
    float acc = 0.f;
    for (int l = 0; l < 32; ++l) {
        const float* xr = P1 + (size_t)(16 * n + l) * ODC + off + g * 64;
        for (int d = 0; d < 64; ++d) acc += (xr[d] + pe[l * 64 + d]) * w1[(size_t)(l * 64 + d) * 64 + j];
    }
    HID[((size_t)n * 4 + g) * 64 + j] = gelu_tanh(acc);
}
__global__ void __launch_bounds__(64) k_cmp_out(const float* HID, const float* w2, float* CMP) {
    const int n = blockIdx.x, g = blockIdx.y, d = threadIdx.x;
    const float* h = HID + ((size_t)n * 4 + g) * 64;
    float acc = 0.f;
    for (int j = 0; j < 64; ++j) acc += h[j] * w2[j * 64 + d];
    CMP[((size_t)n * 4 + g) * 64 + d] = acc;
}
__global__ void __launch_bounds__(256) k_nsa(const float* P1, const float* CK, const float* CV, float* ATT) {
    const int t = blockIdx.x, g = blockIdx.y, tid = threadIdx.x, r = tid >> 6, lane = tid & 63, h = g * 4 + r;
    __shared__ float qs[4][64];
    __shared__ float sc[4][512];
    __shared__ float imp[64];
    __shared__ int sel[8];
    const float* row = P1 + (size_t)t * ODC;
    qs[r][lane] = row[h * 64 + lane] * 0.125f;
    const float slope = exp2f(-0.5f * (float)(h + 1));
    __syncthreads();
    const float* q = qs[r];
    int nv = (t >= 31) ? ((t - 31) / 16 + 1) : 0; if (nv > 255) nv = 255;
    float mx = -INFINITY;
    for (int n = lane; n < 256; n += 64) {
        float s = -INFINITY;
        if (n < nv) {
            const float* kr = CK + ((size_t)n * 4 + g) * 64;
            float a = 0.f;
            for (int d = 0; d < 64; ++d) a += q[d] * kr[d];
            s = a - slope * (float)(t - (16 * n + 31));
        }
        sc[r][n] = s; mx = fmaxf(mx, s);
    }
    mx = wave_max(mx);
    float den = 0.f;
    for (int n = lane; n < 256; n += 64) { const float e = (n < nv) ? expf(sc[r][n] - mx) : 0.f; sc[r][n] = e; den += e; }
    den = wave_sum(den);
    const float inv = den > 0.f ? 1.f / den : 0.f;
    for (int n = lane; n < 256; n += 64) sc[r][n] *= inv;
    __syncthreads();
    float oc = 0.f;
    for (int n = 0; n < nv; ++n) oc += sc[r][n] * CV[((size_t)n * 4 + g) * 64 + lane];
    if (r == 0) {
        float im = 0.f;
        for (int n = 4 * lane - 1; n <= 4 * lane + 3; ++n) if (n >= 0 && n < 255) im += sc[0][n] + sc[1][n] + sc[2][n] + sc[3][n];
        const int cur = t >> 6, ahead = cur - lane; const bool valid = ahead >= 0; const bool forced = (lane == 0) || (valid && ahead < 2);
        float score = valid ? im + (forced ? 100.f : 0.f) : -100.f;
        for (int it = 0; it < 8; ++it) {
            float bv = score; int bi = lane;
#pragma unroll
            for (int o = 32; o > 0; o >>= 1) { const float ov = __shfl_xor(bv, o); const int oi = __shfl_xor(bi, o); if (ov > bv || (ov == bv && oi < bi)) { bv = ov; bi = oi; } }
            if (lane == 0) sel[it] = bi;
            if (lane == bi) score = -INFINITY;
        }
    }
    __syncthreads();
    mx = -INFINITY;
    for (int m = lane; m < 512; m += 64) {
        const int tok = sel[m >> 6] * 64 + (m & 63);
        float s = -INFINITY;
        if (tok <= t) {
            const float* kr = row + (long)(tok - t) * ODC + 1536 + g * 64;
            float a = 0.f;
            for (int d = 0; d < 64; ++d) a += q[d] * kr[d];
            s = a - slope * (float)(t - tok);
        }
        sc[r][m] = s; mx = fmaxf(mx, s);
    }
    mx = wave_max(mx);
    den = 0.f;
    for (int m = lane; m < 512; m += 64) { const float s = sc[r][m]; const float e = (s > -INFINITY) ? expf(s - mx) : 0.f; sc[r][m] = e; den += e; }
    den = wave_sum(den);
    const float inv_s = den > 0.f ? 1.f / den : 0.f;
    __syncthreads();
    float os = 0.f;
    for (int m = 0; m < 512; ++m) {
        const float p = sc[r][m];
        if (p != 0.f) { const int tok = sel[m >> 6] * 64 + (m & 63); os += p * row[(long)(tok - t) * ODC + 1792 + g * 64 + lane]; }
    }
    os *= inv_s;
    __syncthreads();
    mx = -INFINITY;
    for (int m = lane; m < 512; m += 64) {
        const int pos = t - 511 + m;
        float s = -INFINITY;
        if (pos >= 0) {
            const float* kr = row + (long)(pos - t) * ODC + 2048 + g * 64;
            float a = 0.f;
            for (int d = 0; d < 64; ++d) a += q[d] * kr[d];
            s = a - slope * (float)(t - pos);
        }
        sc[r][m] = s; mx = fmaxf(mx, s);
    }
    mx = wave_max(mx);
    den = 0.f;
    for (int m = lane; m < 512; m += 64) { const float s = sc[r][m]; const float e = (s > -INFINITY) ? expf(s - mx) : 0.f; sc[r][m] = e; den += e; }
    den = wave_sum(den);
    const float inv_w = den > 0.f ? 1.f / den : 0.f;
    __syncthreads();
    float ow = 0.f;
    for (int m = 0; m < 512; ++m) {
        const float p = sc[r][m];
        if (p != 0.f) { const int pos = t - 511 + m; ow += p * row[(long)(pos - t) * ODC + 2304 + g * 64 + lane]; }
    }
    ow *= inv_w;
    const float g0 = sigmoidf_(row[2560 + h * 3 + 0]), g1 = sigmoidf_(row[2560 + h * 3 + 1]), g2 = sigmoidf_(row[2560 + h * 3 + 2]);
    ATT[(size_t)t * D + h * 64 + lane] = g0 * oc + g1 * os + g2 * ow;
}
}

extern "C" void kernel_launch(void* const* d_in, const int* in_sizes, int n_in, void* d_out, int out_size, void* d_ws, size_t ws_size, hipStream_t stream) {
    const float* x = (const float*)d_in[0];
    const float* c = (const float*)d_in[1];
    const float* ada_w = (const float*)d_in[2];
    const float* ada_b = (const float*)d_in[3];
    const float* norm1_g = (const float*)d_in[4];
    const float* norm2_g = (const float*)d_in[5];
    const float* ffn_w_up = (const float*)d_in[6];
    const float* ffn_conv_w = (const float*)d_in[7];
    const float* ffn_conv_b = (const float*)d_in[8];
    const float* ffn_w_down = (const float*)d_in[9];
    const float* ev_w_in = (const float*)d_in[10];
    const float* ev_shift_mu = (const float*)d_in[11];
    const float* gla_a_up = (const float*)d_in[12];
    const float* gla_a_b = (const float*)d_in[13];
    const float* gla_norm_g = (const float*)d_in[14];
    const float* rw_w0 = (const float*)d_in[15];
    const float* rw_w2 = (const float*)d_in[16];
    const float* rw_a0 = (const float*)d_in[17];
    const float* rw_a2 = (const float*)d_in[18];
    const float* rw_g2 = (const float*)d_in[19];
    const float* rw_k_k = (const float*)d_in[20];
    const float* rw_k_a = (const float*)d_in[21];
    const float* rw_r_k = (const float*)d_in[22];
    const float* rw_gn_w = (const float*)d_in[23];
    const float* rw_gn_b = (const float*)d_in[24];
    const float* ev_w_out = (const float*)d_in[25];
    const float* od_w_in = (const float*)d_in[26];
    const float* cmp_pe_k = (const float*)d_in[27];
    const float* cmp_w1_k = (const float*)d_in[28];
    const float* cmp_w2_k = (const float*)d_in[29];
    const float* cmp_pe_v = (const float*)d_in[30];
    const float* cmp_w1_v = (const float*)d_in[31];
    const float* cmp_w2_v = (const float*)d_in[32];
    const float* od_w_out = (const float*)d_in[33];
    const float* final_norm_g = (const float*)d_in[34];
    float* X = (float*)d_out;
    float* ws = (float*)d_ws;
    size_t off = 0;
    auto take = [&](size_t n) { float* p = ws + off; off += (n + 63) & ~(size_t)63; return p; };
    float* MOD = take((size_t)DEPTH * NB * 6 * D);
    float* HN = take((size_t)T * D);
    float* MIX = take((size_t)T * D);
    float* BIG = take((size_t)T * 9216);
    float* P0 = BIG;
    float* PRW = P0 + (size_t)T * EVC;
    float* LOGA = PRW + (size_t)T * RWC;
    float* Wd = LOGA + (size_t)T * 256;
    float* Aa = Wd + (size_t)T * 512;
    float* Gg = Aa + (size_t)T * 512;
    float* KK = Gg + (size_t)T * 512;
    float* K2 = KK + (size_t)T * 512;
    float* GO = K2 + (size_t)T * 512;
    float* YY = GO + (size_t)T * 512;
    float* UV = BIG; float* Hh = BIG + (size_t)T * 2 * F;
    float* P1 = BIG;
    float* HID = P1 + (size_t)T * ODC;
    float* CK = HID + 65536; float* CV = CK + 65536;
    if ((size_t)(YY + (size_t)T * 512 - ws) * 4 > ws_size) { fprintf(stderr, "ws too small\n"); return; }

    (void)hipMemcpyAsync(X, x, (size_t)NB * T * D * 4, hipMemcpyDeviceToDevice, stream);
    k_mod<<<dim3(6 * D / 256, NB, DEPTH), 256, 0, stream>>>(c, ada_w, ada_b, MOD);
    for (int layer = 0; layer < DEPTH; ++layer) {
        for (int b = 0; b < NB; ++b) {
            float* Xb = X + (size_t)b * T * D;
            const float* mod = MOD + ((size_t)layer * NB + b) * 6 * D;
            const float *sh1 = mod, *sc1 = mod + D, *g1 = mod + 2 * D, *sh2 = mod + 3 * D, *sc2 = mod + 4 * D, *g2 = mod + 5 * D;
            k_norm<<<T, 256, 0, stream>>>(Xb, norm1_g + layer * D, sh1, sc1, HN);
            if (layer % 2 == 0) {
                k_gemm<<<dim3((EVC + 127) / 128, T / 128), 256, 0, stream>>>(HN, D, ev_w_in, EVC, P0, EVC, T, EVC, D, 0, nullptr, nullptr);
                k_gla_loga<<<T, 256, 0, stream>>>(P0, gla_a_up, gla_a_b, LOGA);
                k_gla_scan<<<4, 128, 0, stream>>>(P0, LOGA, GO);
                k_gla_out<<<dim3(T, 4), 128, 0, stream>>>(GO, P0, gla_norm_g, MIX);
                k_rw_shift<<<T, 256, 0, stream>>>(P0, ev_shift_mu, PRW);
                k_rw_lora<<<T, 512, 0, stream>>>(PRW, rw_w0, rw_w2, rw_a0, rw_a2, rw_g2, Wd, Aa, Gg);
                k_rw_kk<<<dim3(T, 8), 64, 0, stream>>>(PRW, Aa, rw_k_k, rw_k_a, KK, K2);
                k_rw_scan<<<8, 64, 0, stream>>>(PRW, Wd, Aa, KK, K2, YY);
                k_rw_out<<<dim3(T, 8), 64, 0, stream>>>(YY, PRW, K2, Gg, rw_r_k, rw_gn_w, rw_gn_b, MIX);
                k_gemm<<<dim3(D / 128, T / 128), 256, 0, stream>>>(MIX, D, ev_w_out, D, Xb, D, T, D, D, 1, Xb, g1);
            } else {
                k_gemm<<<dim3((ODC + 127) / 128, T / 128), 256, 0, stream>>>(HN, D, od_w_in, ODC, P1, ODC, T, ODC, D, 0, nullptr, nullptr);
                k_cmp_hidden<<<dim3(255, 4), 64, 0, stream>>>(P1, 1024, cmp_pe_k, cmp_w1_k, HID);
                k_cmp_out<<<dim3(255, 4), 64, 0, stream>>>(HID, cmp_w2_k, CK);
                k_cmp_hidden<<<dim3(255, 4), 64, 0, stream>>>(P1, 1280, cmp_pe_v, cmp_w1_v, HID);
                k_cmp_out<<<dim3(255, 4), 64, 0, stream>>>(HID, cmp_w2_v, CV);
                k_nsa<<<dim3(T, 4), 256, 0, stream>>>(P1, CK, CV, MIX);
                k_gemm<<<dim3(D / 128, T / 128), 256, 0, stream>>>(MIX, D, od_w_out, D, Xb, D, T, D, D, 1, Xb, g1);
            }
            k_norm<<<T, 256, 0, stream>>>(Xb, norm2_g + layer * D, sh2, sc2, HN);
            k_gemm<<<dim3(2 * F / 128, T / 128), 256, 0, stream>>>(HN, D, ffn_w_up + (size_t)layer * D * 2 * F, 2 * F, UV, 2 * F, T, 2 * F, D, 0, nullptr, nullptr);
            k_conv<<<T, 256, 0, stream>>>(UV, ffn_conv_w + (size_t)layer * 3 * F, ffn_conv_b + (size_t)layer * F, Hh);
            k_gemm<<<dim3(D / 128, T / 128), 256, 0, stream>>>(Hh, F, ffn_w_down + (size_t)layer * F * D, D, Xb, D, T, D, F, 1, Xb, g2);
        }
    }
    k_norm<<<NB * T, 256, 0, stream>>>(X, final_norm_g, nullptr, nullptr, X);
}
```

```cpp
#include <hip/hip_runtime.h>
#include <hip/hip_cooperative_groups.h>
#include <cstdio>
#include <cstdint>
namespace cg = cooperative_groups;
namespace pg8 {
#define PG8_LAS __attribute__((address_space(3)))
typedef unsigned short bf16_t;
typedef short bf16x8 __attribute__((ext_vector_type(8)));
typedef float f32x4 __attribute__((ext_vector_type(4)));
typedef unsigned u32x4 __attribute__((ext_vector_type(4)));
constexpr int BM = 256, BK = 64, HALF = 128, HTB = HALF * BK * 2  , STAGE_BYTES = 8 * HTB, NXCD = 8, WGM = 8;

__host__ __device__ __forceinline__ int lds_byte(int r, int c) { const int st = (r >> 4) * 2 + (c >> 5), rr = r & 15, cc = c & 31, ob = rr * 64 + cc * 2; return st * 1024 + (ob ^ (((ob >> 9) & 1) << 5)); }
__host__ __device__ __forceinline__ void stage_rc(int b, int& R, int& C) { const int st = b / 1024, sb = b % 1024, swz = sb ^ (((sb >> 9) & 1) << 5); R = (st >> 1) * 16 + swz / 64; C = (st & 1) * 32 + (swz % 64) / 2; }
__host__ __device__ __forceinline__ int perm32(int rho) { const int n = rho >> 4, i = rho & 15; return 8 * (i >> 2) + 4 * n + (i & 3); }

struct Unit { int pm, pn; };
struct Gemm { const bf16_t* A; const bf16_t* Bt; int M, N, K; int a_rows; };

struct StaticOrder {
    int nM, nN, nwg, G, c;
    __host__ __device__ void init(int M, int N, int G_, int c_) { nM = M / BM; nN = N / BM; nwg = nM * nN; G = G_; c = c_; }
    __host__ __device__ void init_tiles(int nM_, int nN_, int G_, int c_) { nM = nM_; nN = nN_; nwg = nM * nN; G = G_; c = c_; }
    __host__ __device__ bool next(int i, Unit& u) const {
        const long L = (long)i * G + c; if (L >= nwg) return false;
        int wgid = (int)L; { const int q = nwg / NXCD, r = nwg % NXCD, xcd = wgid % NXCD, off = wgid / NXCD; wgid = (xcd < r ? xcd * (q + 1) : r * (q + 1) + (xcd - r) * q) + off; }
        const int nig = WGM * nN, gid = wgid / nig, fm = gid * WGM, gsz = (nM - fm) < WGM ? (nM - fm) : WGM;
        u.pm = fm + ((wgid % nig) % gsz); u.pn = (wgid % nig) / gsz; return true;
    }
    __device__ __forceinline__ void a_ready(const Unit&) const {}
    __device__ __forceinline__ void done(const Unit&) const {}
};

template <class Epi, class Sched, bool ALIGN_EPI = false, bool SP2 = false>
__device__ __forceinline__ void gemm_phase(PG8_LAS unsigned char* lds, const Gemm g, const Sched& S, const Epi& E) {
    int tid_o = threadIdx.x; asm volatile("" : "+v"(tid_o));
    const int tid = tid_o, wid = __builtin_amdgcn_readfirstlane(tid >> 6), lane = tid & 63, wr = wid >> 2, wc = wid & 3, fr = lane & 15, fq = lane >> 4;
    const int K = g.K, nt = K / BK;
    unsigned voffA[2], voffB[2];
#pragma unroll
    for (int i = 0; i < 2; ++i) { int R, C; stage_rc(tid * 16 + i * 8192, R, C); const int Rb = Epi::PERM ? ((R & ~31) + perm32(R & 31)) : R;
        voffA[i] = (unsigned)(R * K + C) * 2u; voffB[i] = (unsigned)(Rb * K + C) * 2u; }
    const size_t kstep = (size_t)(BK * 2);
    const size_t hstep = (size_t)HALF * K * 2;
    const size_t tstep = 2 * hstep;
    const unsigned ldsw = (unsigned)wid * 1024u;
    const int aoff = lds_byte(wr * 64 + fr, fq * 8), boff = lds_byte(wc * 32 + fr, fq * 8);
#define PG8_SA(b, h) (((b) * 2 + (h)) * HTB)
#define PG8_SB(b, h) ((4 + (b) * 2 + (h)) * HTB)
#define PG8_STAGE(bufoff, gbase, voff) do { _Pragma("unroll") for (int _i = 0; _i < 2; ++_i) \
        __builtin_amdgcn_global_load_lds((const unsigned*)((const char*)(gbase) + (voff)[_i]), (PG8_LAS unsigned*)(lds + (bufoff) + ldsw + _i * 8192), 16, 0, 0); } while (0)
#define PG8_LDA(dst, b, h) do { _Pragma("unroll") for (int m = 0; m < 4; ++m) _Pragma("unroll") for (int k = 0; k < 2; ++k) dst[m][k] = *(const PG8_LAS bf16x8*)(lds + PG8_SA(b, h) + aoff + m * 2048 + k * 1024); } while (0)
#define PG8_LDB(dst, b, h) do { _Pragma("unroll") for (int n = 0; n < 2; ++n) _Pragma("unroll") for (int k = 0; k < 2; ++k) dst[n][k] = *(const PG8_LAS bf16x8*)(lds + PG8_SB(b, h) + boff + n * 2048 + k * 1024); } while (0)
#define PG8_MMA(ai, bj, At, Bt) do { __builtin_amdgcn_s_setprio(1); _Pragma("unroll") for (int m = 0; m < 4; ++m) _Pragma("unroll") for (int n = 0; n < 2; ++n) _Pragma("unroll") for (int k = 0; k < 2; ++k) \
        acc[ai][bj][m][n] = __builtin_amdgcn_mfma_f32_16x16x32_bf16(Bt[n][k], At[m][k], acc[ai][bj][m][n], 0, 0, 0); __builtin_amdgcn_s_setprio(0); } while (0)
#define PG8_WAIT_V(n) asm volatile("s_waitcnt vmcnt(" #n ")" ::: "memory")
#define PG8_WAIT_L(n) asm volatile("s_waitcnt lgkmcnt(" #n ")" ::: "memory")
#define PG8_BAR __builtin_amdgcn_s_barrier()
#define PG8_SCHED __builtin_amdgcn_sched_barrier(0)
    Unit cur, nxt; int ui = 0;
    if (!S.next(0, cur)) return;
    f32x4 acc[2][2][4][2];
#pragma unroll
    for (int a = 0; a < 2; ++a)
#pragma unroll
        for (int b = 0; b < 2; ++b)
#pragma unroll
            for (int m = 0; m < 4; ++m)
#pragma unroll
                for (int n = 0; n < 2; ++n) acc[a][b][m][n] = (f32x4){0.f, 0.f, 0.f, 0.f};
    bf16x8 At[4][2], B0[2][2], B1[2][2];
    const size_t tstepA = (size_t)g.a_rows * K * 2; const char* cA = (const char*)g.A + (size_t)cur.pm * tstepA; const char* cB = (const char*)g.Bt + (size_t)cur.pn * tstep;
    S.a_ready(cur);
    if constexpr (SP2) {
        PG8_STAGE(PG8_SB(0, 0), cB, voffB); PG8_STAGE(PG8_SB(0, 1), cB + hstep, voffB); PG8_STAGE(PG8_SA(0, 0), cA, voffA); PG8_STAGE(PG8_SA(0, 1), cA + hstep, voffA);
        if (wr == 1) PG8_BAR;
        PG8_WAIT_V(2); PG8_BAR;
        PG8_STAGE(PG8_SB(1, 0), cB + kstep, voffB); PG8_STAGE(PG8_SA(1, 0), cA + kstep, voffA); PG8_STAGE(PG8_SB(1, 1), cB + hstep + kstep, voffB);
        PG8_WAIT_V(6); PG8_BAR;
    } else {
        PG8_STAGE(PG8_SB(0, 0), cB, voffB); PG8_STAGE(PG8_SA(0, 0), cA, voffA); PG8_STAGE(PG8_SB(0, 1), cB + hstep, voffB); PG8_STAGE(PG8_SA(0, 1), cA + hstep, voffA);
        if (wr == 1) PG8_BAR;
        PG8_WAIT_V(4); PG8_BAR;
        PG8_STAGE(PG8_SB(1, 0), cB + kstep, voffB); PG8_STAGE(PG8_SA(1, 0), cA + kstep, voffA); PG8_STAGE(PG8_SB(1, 1), cB + hstep + kstep, voffB);
        PG8_WAIT_V(6); PG8_BAR;
    }
    for (;;) {
        const bool has_next = S.next(ui + 1, nxt);
        const char* nA = has_next ? (const char*)g.A + (size_t)nxt.pm * tstepA : cA; const char* nB = has_next ? (const char*)g.Bt + (size_t)nxt.pn * tstep : cB;
#pragma unroll 1
        for (int t = 0; t < nt; t += 2) {
            const bool last = (t == nt - 2);
            const char* a1 = cA + (size_t)(t + 1) * kstep;
            const char* a2 = last ? nA : cA + (size_t)(t + 2) * kstep; const char* b2 = last ? nB : cB + (size_t)(t + 2) * kstep;
            const char* a3 = a2 + kstep; const char* b3 = b2 + kstep;
            if (last && has_next) S.a_ready(nxt);
            if constexpr (SP2) {
            PG8_LDB(B0, 0, 0); PG8_LDB(B1, 0, 1); PG8_SCHED; PG8_LDA(At, 0, 0); PG8_STAGE(PG8_SA(1, 1), a1 + hstep, voffA);
            PG8_WAIT_V(8); PG8_WAIT_L(0); PG8_BAR; PG8_MMA(0, 0, At, B0); PG8_MMA(0, 1, At, B1); PG8_BAR; PG8_SCHED;
            PG8_LDA(At, 0, 1); PG8_STAGE(PG8_SB(0, 0), b2, voffB); PG8_STAGE(PG8_SB(0, 1), b2 + hstep, voffB); PG8_STAGE(PG8_SA(0, 0), a2, voffA);
            PG8_WAIT_V(8); PG8_WAIT_L(0); PG8_BAR; PG8_MMA(1, 0, At, B0); PG8_MMA(1, 1, At, B1); PG8_BAR; PG8_SCHED;
            PG8_LDB(B0, 1, 0); PG8_LDB(B1, 1, 1); PG8_SCHED; PG8_LDA(At, 1, 0); PG8_STAGE(PG8_SA(0, 1), a2 + hstep, voffA);
            PG8_WAIT_V(8); PG8_WAIT_L(0); PG8_BAR; PG8_MMA(0, 0, At, B0); PG8_MMA(0, 1, At, B1); PG8_BAR; PG8_SCHED;
            PG8_LDA(At, 1, 1); PG8_STAGE(PG8_SB(1, 0), b3, voffB); PG8_STAGE(PG8_SB(1, 1), b3 + hstep, voffB); PG8_STAGE(PG8_SA(1, 0), a3, voffA);
            PG8_WAIT_V(8); PG8_WAIT_L(0); PG8_BAR; PG8_MMA(1, 0, At, B0); PG8_MMA(1, 1, At, B1); PG8_BAR; PG8_SCHED;
            } else {
            PG8_LDB(B0, 0, 0); PG8_SCHED; PG8_LDA(At, 0, 0); PG8_STAGE(PG8_SA(1, 1), a1 + hstep, voffA);
            PG8_WAIT_L(8); PG8_BAR; PG8_WAIT_L(0); PG8_MMA(0, 0, At, B0); PG8_BAR; PG8_SCHED;
            PG8_LDB(B1, 0, 1); PG8_STAGE(PG8_SB(0, 0), b2, voffB);
            PG8_BAR; PG8_WAIT_L(0); PG8_MMA(0, 1, At, B1); PG8_BAR;
            PG8_LDA(At, 0, 1); PG8_STAGE(PG8_SA(0, 0), a2, voffA);
            PG8_BAR; PG8_WAIT_L(0); PG8_MMA(1, 0, At, B0); PG8_BAR; PG8_SCHED;
            PG8_STAGE(PG8_SB(0, 1), b2 + hstep, voffB);
            PG8_WAIT_V(6); PG8_BAR; PG8_MMA(1, 1, At, B1); PG8_BAR;
            PG8_LDB(B0, 1, 0); PG8_SCHED; PG8_LDA(At, 1, 0); PG8_STAGE(PG8_SA(0, 1), a2 + hstep, voffA);
            PG8_WAIT_L(8); PG8_BAR; PG8_WAIT_L(0); PG8_MMA(0, 0, At, B0); PG8_BAR; PG8_SCHED;
            PG8_LDB(B1, 1, 1); PG8_STAGE(PG8_SB(1, 0), b3, voffB);
            PG8_BAR; PG8_WAIT_L(0); PG8_MMA(0, 1, At, B1); PG8_BAR;
            PG8_LDA(At, 1, 1); PG8_STAGE(PG8_SA(1, 0), a3, voffA);
            PG8_BAR; PG8_WAIT_L(0); PG8_MMA(1, 0, At, B0); PG8_BAR; PG8_SCHED;
            PG8_STAGE(PG8_SB(1, 1), b3 + hstep, voffB);
            PG8_WAIT_V(6); PG8_BAR; PG8_MMA(1, 1, At, B1); PG8_BAR;
            }
        }
        if constexpr (ALIGN_EPI) { if (wr == 0) PG8_BAR; }
        if constexpr (!Epi::AFTER_DRAIN) { E(acc, cur, wr, wc, fr, fq); S.done(cur); }
        if (!has_next) break;
#pragma unroll
        for (int a = 0; a < 2; ++a)
#pragma unroll
            for (int b = 0; b < 2; ++b)
#pragma unroll
                for (int m = 0; m < 4; ++m)
#pragma unroll
                    for (int n = 0; n < 2; ++n) acc[a][b][m][n] = (f32x4){0.f, 0.f, 0.f, 0.f};
        cur = nxt; cA = nA; cB = nB; ++ui;
        if constexpr (ALIGN_EPI) { if (wr == 1) PG8_BAR; }
    }
    PG8_WAIT_V(0);
    if constexpr (!ALIGN_EPI) { if (wr == 0) PG8_BAR; }
    PG8_BAR;
    if constexpr (Epi::AFTER_DRAIN) { E.fused(acc, cur, wr, wc, fr, fq, lds, wid, lane); S.done(cur); }
#undef PG8_SA
#undef PG8_SB
#undef PG8_STAGE
#undef PG8_LDA
#undef PG8_LDB
#undef PG8_MMA
#undef PG8_WAIT_V
#undef PG8_WAIT_L
#undef PG8_BAR
#undef PG8_SCHED
}
}

#ifndef PG8_SP2
#define PG8_SP2 true
#endif
#ifndef PG8_ALIGN
#define PG8_ALIGN true
#endif

namespace mk {
using pg8::bf16_t; using pg8::bf16x8; using pg8::f32x4; using pg8::u32x4; using pg8::Unit;
typedef float f32x16 __attribute__((ext_vector_type(16)));
typedef short bf16x4 __attribute__((ext_vector_type(4)));
typedef unsigned u32x2 __attribute__((ext_vector_type(2)));
#define LAS __attribute__((address_space(3)))

constexpr int D = 1024, NB = 4, T = 4096, M = NB * T, F = 2816;
constexpr int P0W = 3584, P1W = 2816, LIW = 384, LOW = 1792;
constexpr float EPS = 1e-6f, LOG2E = 1.4426950408889634f;
constexpr int NWAVES = 8, NTHREADS = 512;

constexpr size_t MiB = 1u << 20;
constexpr size_t WS_CTL = 0;
constexpr size_t WS_MOD = 1 * MiB;
constexpr size_t WS_CBIAS = WS_MOD + 256 * 1024;
constexpr size_t WS_WEVIN = 2 * MiB;
constexpr size_t WS_WLORA = 9 * MiB;
constexpr size_t WS_WEVOUT = 11 * MiB;
constexpr size_t WS_WUP = 13 * MiB;
constexpr size_t WS_WDN = 35 * MiB;
constexpr size_t WS_WODIN = 46 * MiB;
constexpr size_t WS_WODOUT = 52 * MiB;
constexpr size_t WS_W1T = 54 * MiB;
constexpr size_t WS_HNA = 55 * MiB;
constexpr size_t WS_HN = WS_HNA + 2 * D * 2;
constexpr size_t WS_BIG = 88 * MiB;
constexpr size_t WS_P0 = WS_BIG;
constexpr size_t WS_LI = WS_BIG + 112 * MiB;
constexpr size_t WS_Y = WS_BIG + 124 * MiB;
constexpr size_t WS_BON = WS_BIG + 156 * MiB;
constexpr size_t WS_H = WS_BIG;
constexpr size_t WS_P1 = WS_BIG;
constexpr size_t WS_VTS = WS_BIG + 88 * MiB;
constexpr size_t WS_VTW = WS_BIG + 96 * MiB;
constexpr size_t WS_CMPK = WS_BIG + 104 * MiB;
constexpr size_t WS_CMPVT = WS_CMPK + 512 * 1024;
constexpr size_t WS_END = WS_BIG + 157 * MiB;
constexpr int LDS_BYTES = 147456;
constexpr int LDS_HALO = 131072;

__device__ __forceinline__ float bf2f(bf16_t b) { return __uint_as_float((unsigned)b << 16); }
__device__ __forceinline__ float lo_bf(unsigned w) { return __uint_as_float(w << 16); }
__device__ __forceinline__ float hi_bf(unsigned w) { return __uint_as_float(w & 0xffff0000u); }
typedef float f32x2_t __attribute__((ext_vector_type(2))); typedef __bf16 bf16x2_t __attribute__((ext_vector_type(2)));
__device__ __forceinline__ unsigned pk_bf16(float lo, float hi) { f32x2_t v = {lo, hi}; bf16x2_t b = __builtin_convertvector(v, bf16x2_t); return __builtin_bit_cast(unsigned, b); }
__device__ __forceinline__ bf16_t f2bf(float f) { return (bf16_t)(pk_bf16(f, 0.f) & 0xffffu); }
__device__ __forceinline__ float frcp(float x) { return __builtin_amdgcn_rcpf(x); }
__device__ __forceinline__ float fsigmoid(float x) { return frcp(1.f + __expf(-x)); }
__device__ __forceinline__ float fsilu(float x) { return x * frcp(1.f + __expf(-x)); }
__device__ __forceinline__ float ftanh(float x) { return 2.f * frcp(1.f + __expf(-2.f * x)) - 1.f; }
__device__ __forceinline__ float fsoftplus(float x) { return fmaxf(x, 0.f) + __logf(1.f + __expf(-fabsf(x))); }
__device__ __forceinline__ float fgelu(float x) { const float y = 0.7978845608028654f * (x + 0.044715f * x * x * x); return x * frcp(1.f + __expf(-2.f * y)); }
__device__ __forceinline__ float wave_sum(float v) {
#pragma unroll
    for (int o = 32; o > 0; o >>= 1) v += __shfl_xor(v, o);
    return v;
}
template <int CTRL> __device__ __forceinline__ float dppf(float x) { return __builtin_bit_cast(float, __builtin_amdgcn_update_dpp(0, __builtin_bit_cast(int, x), CTRL, 0xf, 0xf, true)); }
__device__ __forceinline__ float red16(float x) { x += dppf<0xB1>(x); x += dppf<0x4E>(x); x += dppf<0x124>(x); x += dppf<0x128>(x); return x; }
#define LDS_WAIT() asm volatile("s_waitcnt lgkmcnt(0)" ::: "memory")
#define BLOCK_SYNC() __syncthreads()

struct Ptrs {
    const float* in[35];
    float* out;
    unsigned char* ws;
};

__device__ __forceinline__ void conv_item(const float* W, int ldw, int k0, int n0, int kvalid, int nvalid, bf16_t* WT, int ldt, int drow0, int dk0, LAS float* scr, int lane) {
    const int nn = lane & 31;
#pragma unroll 8
    for (int i = 0; i < 32; ++i) { const int kk = 2 * i + (lane >> 5); float v = 0.f; if (W != nullptr && kk < kvalid && nn < nvalid) v = W[(size_t)(k0 + kk) * ldw + n0 + nn]; scr[kk * 33 + nn] = v; }
    LDS_WAIT(); asm volatile("" ::: "memory");
    const int c = lane & 7;
#pragma unroll
    for (int j = 0; j < 4; ++j) { const int n = (lane >> 3) + 8 * j; const LAS float* s = scr + (8 * c) * 33 + n;
        u32x4 o; o.x = pk_bf16(s[0 * 33], s[1 * 33]); o.y = pk_bf16(s[2 * 33], s[3 * 33]); o.z = pk_bf16(s[4 * 33], s[5 * 33]); o.w = pk_bf16(s[6 * 33], s[7 * 33]);
        *(u32x4*)(WT + (size_t)(drow0 + n) * ldt + dk0 + 8 * c) = o; }
    LDS_WAIT(); asm volatile("" ::: "memory");
}

__device__ __forceinline__ void prologue(const Ptrs& P, LAS unsigned char* lds, int tid, int lane, int wave, int bid, int G) {
    unsigned char* ws = P.ws;
    {
        LAS float* sc = (LAS float*)(lds + 72 * 1024);
        LAS float* part = sc + 4096;
        const float* c = P.in[1];
        for (int i = tid; i < 4096; i += NTHREADS) sc[i] = fsilu(c[i]);
        BLOCK_SYNC();
        for (int cb = bid; cb < 256; cb += G) {
            const int l = cb >> 7, j0 = (cb & 127) * 48;
            if (tid < 480) {
                const int kg = tid / 48, cj = tid % 48;
                const float* w = P.in[2] + (size_t)l * D * 6144 + j0 + cj;
                float a0 = 0.f, a1 = 0.f, a2 = 0.f, a3 = 0.f;
                for (int k = kg; k < D; k += 10) { const float wv = w[(size_t)k * 6144]; a0 += sc[k] * wv; a1 += sc[1024 + k] * wv; a2 += sc[2048 + k] * wv; a3 += sc[3072 + k] * wv; }
                part[(kg * 4 + 0) * 48 + cj] = a0; part[(kg * 4 + 1) * 48 + cj] = a1; part[(kg * 4 + 2) * 48 + cj] = a2; part[(kg * 4 + 3) * 48 + cj] = a3;
            }
            BLOCK_SYNC();
            if (tid < 192) {
                const int b = tid / 48, cj = tid % 48;
                float s = P.in[3][l * 6144 + j0 + cj];
                for (int kg = 0; kg < 10; ++kg) s += part[(kg * 4 + b) * 48 + cj];
                ((float*)(ws + WS_MOD))[((size_t)l * NB + b) * 6144 + j0 + cj] = s;
            }
            BLOCK_SYNC();
        }
        if (bid >= G - 2) {
            const int which = bid - (G - 2);
            const float* pe = P.in[which ? 30 : 27]; const float* w1 = P.in[which ? 31 : 28];
            const int j = tid & 63, pt = tid >> 6;
            float a = 0.f;
            for (int k = pt * 256; k < pt * 256 + 256; ++k) a += pe[k] * w1[(size_t)k * 64 + j];
            part[pt * 64 + j] = a;
            BLOCK_SYNC();
            if (tid < 64) { float s = 0.f; for (int p = 0; p < 8; ++p) s += part[p * 64 + tid]; ((float*)(ws + WS_CBIAS))[which * 64 + tid] = s; }
            BLOCK_SYNC();
        }
    }
    LAS float* scr = (LAS float*)(lds + wave * 8448);
    const int gw = bid * NWAVES + wave, NGW = G * NWAVES;
    constexpr int I_EVIN = 16 * 112, I_LORA = 6 * 56, I_EVOUT = 16 * 32, I_UP = 16 * 176, I_DN = 44 * 32, I_ODIN = 16 * 88, I_ODOUT = 16 * 32, I_W1 = 32 * 2;
    constexpr int NITEMS = I_EVIN + I_LORA + I_EVOUT + 2 * I_UP + 2 * I_DN + I_ODIN + I_ODOUT + 2 * I_W1;
    for (int it = gw; it < NITEMS; it += NGW) {
        int r = it;
        if (r < I_EVIN) { const int kb = r / 112, nb = r % 112, n0 = nb * 32; const int nv = 3344 - n0;
            conv_item(nv > 0 ? P.in[10] : nullptr, 3344, kb * 64, n0, 64, nv, (bf16_t*)(ws + WS_WEVIN), D, n0, kb * 64, scr, lane); continue; } r -= I_EVIN;
        if (r < I_LORA) { const int kb = r / 56, nb = r % 56, n0 = nb * 32; const float* W = nullptr; int ldw = 512, sk0 = 0, sn0 = 0, kv = 64;
            if (n0 < 512) { if (kb == 0) { W = P.in[16]; sn0 = n0; } }
            else if (n0 < 1024) { if (kb == 1) { W = P.in[18]; sn0 = n0 - 512; } }
            else if (n0 < 1536) { if (kb == 2 || kb == 3) { W = P.in[19]; sn0 = n0 - 1024; sk0 = (kb - 2) * 64; } }
            else { if (kb == 4) { W = P.in[12]; ldw = 256; sn0 = n0 - 1536; kv = 16; } }
            conv_item(W, ldw, sk0, sn0, kv, 32, (bf16_t*)(ws + WS_WLORA), LIW, n0, kb * 64, scr, lane); continue; } r -= I_LORA;
        if (r < I_EVOUT) { const int kb = r / 32, nb = r % 32; conv_item(P.in[25], D, kb * 64, nb * 32, 64, 32, (bf16_t*)(ws + WS_WEVOUT), D, nb * 32, kb * 64, scr, lane); continue; } r -= I_EVOUT;
        if (r < 2 * I_UP) { const int l = r / I_UP; r %= I_UP; const int kb = r / 176, nb = r % 176, n0 = nb * 32;
            const int f0 = n0 < F ? n0 : n0 - F; const int drow = (f0 >> 7) * 256 + (n0 < F ? 0 : 128) + (f0 & 127);
            conv_item(P.in[6] + (size_t)l * D * 2 * F, 2 * F, kb * 64, n0, 64, 32, (bf16_t*)(ws + WS_WUP) + (size_t)l * 2 * F * D, D, drow, kb * 64, scr, lane); continue; } r -= 2 * I_UP;
        if (r < 2 * I_DN) { const int l = r / I_DN; r %= I_DN; const int kb = r / 32, nb = r % 32;
            conv_item(P.in[9] + (size_t)l * F * D, D, kb * 64, nb * 32, 64, 32, (bf16_t*)(ws + WS_WDN) + (size_t)l * D * F, F, nb * 32, kb * 64, scr, lane); continue; } r -= 2 * I_DN;
        if (r < I_ODIN) { const int kb = r / 88, nb = r % 88, n0 = nb * 32; const int nv = 2608 - n0;
            conv_item(nv > 0 ? P.in[26] : nullptr, 2608, kb * 64, n0, 64, nv, (bf16_t*)(ws + WS_WODIN), D, n0, kb * 64, scr, lane); continue; } r -= I_ODIN;
        if (r < I_ODOUT) { const int kb = r / 32, nb = r % 32; conv_item(P.in[33], D, kb * 64, nb * 32, 64, 32, (bf16_t*)(ws + WS_WODOUT), D, nb * 32, kb * 64, scr, lane); continue; } r -= I_ODOUT;
        { const int which = r / I_W1; r %= I_W1; const int kb = r / 2, nb = r % 2;
            conv_item(P.in[which ? 31 : 28], 64, kb * 64, nb * 32, 64, 32, (bf16_t*)(ws + WS_W1T) + (size_t)which * 64 * 2048, 2048, nb * 32, kb * 64, scr, lane); }
    }
}

__device__ __forceinline__ void norm_phase(const float* X, const float* g, const float* mod  , int sh_off, int sc_off, bf16_t* HN, float* OUTF, int gw, int NGW, int lane) {
    f32x4 gg[4];
#pragma unroll
    for (int j = 0; j < 4; ++j) gg[j] = *(const f32x4*)(g + 4 * lane + 256 * j);
    for (int m = gw; m < M; m += NGW) {
        const f32x4* xr = (const f32x4*)(X + (size_t)m * D) + lane;
        f32x4 v[4]; float s = 0.f;
#pragma unroll
        for (int j = 0; j < 4; ++j) { v[j] = xr[64 * j]; s += (v[j].x * v[j].x + v[j].y * v[j].y) + (v[j].z * v[j].z + v[j].w * v[j].w); }
        const float rstd = rsqrtf(wave_sum(s) * (1.f / D) + EPS);
        if (OUTF) {
            f32x4* o = (f32x4*)(OUTF + (size_t)m * D) + lane;
#pragma unroll
            for (int j = 0; j < 4; ++j) o[64 * j] = v[j] * rstd * gg[j];
        } else {
            const float* mb = mod + (size_t)(m >> 12) * 6144;
            u32x2* o = (u32x2*)(HN + (size_t)m * D) + lane;
#pragma unroll
            for (int j = 0; j < 4; ++j) {
                const f32x4 sc = *(const f32x4*)(mb + sc_off + 4 * lane + 256 * j), sh = *(const f32x4*)(mb + sh_off + 4 * lane + 256 * j);
                const f32x4 y = v[j] * rstd * gg[j] * (sc + 1.f) + sh;
                u32x2 w; w.x = pk_bf16(y.x, y.y); w.y = pk_bf16(y.z, y.w); o[64 * j] = w;
            }
        }
    }
}

struct EpiStore {
    static constexpr bool PERM = true, AFTER_DRAIN = false;
    bf16_t* O; int ldc; int nvalid;
    __device__ __forceinline__ void operator()(const f32x4 (&acc)[2][2][4][2], const Unit& u, int wr, int wc, int fr, int fq) const {
        const int row0 = u.pm * 256 + wr * 64 + fr, col0 = u.pn * 256 + wc * 32 + 8 * fq;
#pragma unroll
        for (int ai = 0; ai < 2; ++ai)
#pragma unroll
            for (int m = 0; m < 4; ++m) { bf16_t* rowp = O + (size_t)(row0 + ai * 128 + m * 16) * ldc + col0;
#pragma unroll
                for (int bj = 0; bj < 2; ++bj) { if (col0 + bj * 128 < nvalid) { const f32x4 v0 = acc[ai][bj][m][0], v1 = acc[ai][bj][m][1];
                    u32x4 w; w.x = pk_bf16(v0[0], v0[1]); w.y = pk_bf16(v0[2], v0[3]); w.z = pk_bf16(v1[0], v1[1]); w.w = pk_bf16(v1[2], v1[3]); *(u32x4*)(rowp + bj * 128) = w; } } }
    }
};
struct EpiLora {
    static constexpr bool PERM = true, AFTER_DRAIN = false;
    bf16_t* O; const float* w0; const float* a0; const float* a_b;
    __device__ __forceinline__ void operator()(const f32x4 (&acc)[2][2][4][2], const Unit& u, int wr, int wc, int fr, int fq) const {
        const int row0 = u.pm * 256 + wr * 64 + fr, col0 = u.pn * 256 + wc * 32 + 8 * fq;
        const int kind = u.pn >> 1;
        const float* bias = kind == 0 ? w0 + col0 : kind == 1 ? a0 + (col0 - 512) : kind == 3 ? a_b + (col0 - 1536) : nullptr;
#pragma unroll
        for (int bj = 0; bj < 2; ++bj)
#pragma unroll
            for (int n = 0; n < 2; ++n) {
                const f32x4 bv = bias ? *(const f32x4*)(bias + bj * 128 + 4 * n) : (f32x4){0.f, 0.f, 0.f, 0.f};
#pragma unroll
                for (int ai = 0; ai < 2; ++ai)
#pragma unroll
                    for (int m = 0; m < 4; ++m) {
                        float v[4];
#pragma unroll
                        for (int e = 0; e < 4; ++e) { const float z = acc[ai][bj][m][n][e] + bv[e]; float o;
                            if (kind == 0) o = -0.6065306597126334f * fsigmoid(z); else if (kind == 1) o = fsigmoid(z); else if (kind == 2) o = z; else o = -fsoftplus(-z) * (1.f / 16.f);
                            v[e] = o; }
                        u32x2 w; w.x = pk_bf16(v[0], v[1]); w.y = pk_bf16(v[2], v[3]);
                        *(u32x2*)(O + (size_t)(row0 + ai * 128 + m * 16) * LOW + col0 + bj * 128 + 4 * n) = w;
                    }
            }
    }
};
struct EpiRes {
    static constexpr bool PERM = true, AFTER_DRAIN = false;
    const float* base; float* out; const float* gate  ;
    __device__ __forceinline__ void operator()(const f32x4 (&acc)[2][2][4][2], const Unit& u, int wr, int wc, int fr, int fq) const {
        const int row0 = u.pm * 256 + wr * 64 + fr, col0 = u.pn * 256 + wc * 32 + 8 * fq;
        const float* gp = gate + (size_t)(u.pm >> 4) * 6144 + col0;
        f32x4 gv[2][2];
#pragma unroll
        for (int bj = 0; bj < 2; ++bj)
#pragma unroll
            for (int n = 0; n < 2; ++n) gv[bj][n] = *(const f32x4*)(gp + bj * 128 + 4 * n);
#pragma unroll
        for (int ai = 0; ai < 2; ++ai)
#pragma unroll
            for (int m = 0; m < 4; ++m) { const size_t off = (size_t)(row0 + ai * 128 + m * 16) * D + col0;
#pragma unroll
                for (int bj = 0; bj < 2; ++bj)
#pragma unroll
                    for (int n = 0; n < 2; ++n) { const f32x4 b = *(const f32x4*)(base + off + bj * 128 + 4 * n); *(f32x4*)(out + off + bj * 128 + 4 * n) = b + gv[bj][n] * acc[ai][bj][m][n]; } }
    }
};
struct EpiConv {
    static constexpr bool PERM = true, AFTER_DRAIN = false;
    bf16_t* H; const float* cw; const float* cb; LAS float* halo;
    __device__ __forceinline__ void operator()(const f32x4 (&acc)[2][2][4][2], const Unit& u, int wr, int wc, int fr, int fq) const {
        const int f0 = u.pn * 128 + wc * 32 + 8 * fq, lcol = wc * 32 + 8 * fq;
        float c0[8], c1[8], c2[8], cbv[8];
#pragma unroll
        for (int e = 0; e < 8; ++e) { c0[e] = cw[f0 + e]; c1[e] = cw[F + f0 + e]; c2[e] = cw[2 * F + f0 + e]; cbv[e] = cb[f0 + e]; }
        if (fr >= 14) {
#pragma unroll
            for (int ai = 0; ai < 2; ++ai)
#pragma unroll
                for (int n = 0; n < 2; ++n) *(LAS f32x4*)(halo + ((ai * 2 + wr) * 2 + (fr - 14)) * 128 + lcol + 4 * n) = acc[ai][0][3][n];
        }
        asm volatile("s_waitcnt lgkmcnt(0)" ::: "memory"); __builtin_amdgcn_s_barrier(); asm volatile("" ::: "memory");
#pragma unroll
        for (int ai = 0; ai < 2; ++ai)
#pragma unroll
            for (int m = 0; m < 4; ++m) {
                const int lrow = ai * 128 + wr * 64 + m * 16 + fr;
                const int grow = u.pm * 254 - 2 + lrow;
                const int t = grow & (T - 1);
                float hA[8], hB[8];
                if (m == 0) {
                    const int idx = ai * 2 + wr - 1;
#pragma unroll
                    for (int e = 0; e < 8; ++e) { hA[e] = 0.f; hB[e] = 0.f; }
                    if (idx >= 0 && fr < 2) {
#pragma unroll
                        for (int n = 0; n < 2; ++n) { const f32x4 a = *(LAS f32x4*)(halo + (idx * 2 + 1) * 128 + lcol + 4 * n), b = *(LAS f32x4*)(halo + (idx * 2 + 0) * 128 + lcol + 4 * n);
#pragma unroll
                            for (int e = 0; e < 4; ++e) { hA[n * 4 + e] = a[e]; hB[n * 4 + e] = b[e]; } }
                    }
                }
                float o[8];
#pragma unroll
                for (int n = 0; n < 2; ++n)
#pragma unroll
                    for (int e = 0; e < 4; ++e) {
                        const float cur = acc[ai][0][m][n][e];
                        float p1 = dppf<0x121>(cur), p2 = dppf<0x122>(cur);
                        if (m > 0) { const float pv = acc[ai][0][m - 1][n][e]; const float q1 = dppf<0x121>(pv), q2 = dppf<0x122>(pv); if (fr < 1) p1 = q1; if (fr < 2) p2 = q2; }
                        else { if (fr < 1) p1 = hA[n * 4 + e]; if (fr < 2) p2 = (fr == 1) ? hA[n * 4 + e] : hB[n * 4 + e]; }
                        if (t == 0) p1 = 0.f;
                        if (t <= 1) p2 = 0.f;
                        const int ee = n * 4 + e;
                        const float uc = cbv[ee] + c0[ee] * p2 + c1[ee] * p1 + c2[ee] * cur;
                        o[ee] = fgelu(uc) * acc[ai][1][m][n][e];
                    }
                if (lrow >= 2 && grow < M) { u32x4 w; w.x = pk_bf16(o[0], o[1]); w.y = pk_bf16(o[2], o[3]); w.z = pk_bf16(o[4], o[5]); w.w = pk_bf16(o[6], o[7]); *(u32x4*)(H + (size_t)grow * F + f0) = w; }
            }
    }
};

__device__ __forceinline__ void lora_in_phase(const bf16_t* P0, const float* mu, bf16_t* LI, int gw, int NGW, int lane) {
    for (int m = gw; m < M; m += NGW) {
        const bf16_t* row = P0 + (size_t)m * P0W; const bool hasp = (m & (T - 1)) != 0;
#pragma unroll
        for (int i = 0; i < 6; ++i) {
            const int j = lane + 64 * i; float o = 0.f;
            if (j < 256) { const int c = j < 64 ? 512 + j : j < 128 ? 1600 + (j - 64) : 1664 + (j - 128);
                const float p = bf2f(row[1552 + c]); const float pp = hasp ? bf2f(row[1552 + c - P0W]) : 0.f; const float s = p + (pp - p) * mu[c];
                o = j < 64 ? ftanh(s) : j < 128 ? s : fsigmoid(s); }
            else if (j < 272) o = bf2f(row[1536 + j - 256]);
            LI[(size_t)m * LIW + j] = f2bf(o);
        }
    }
}

__device__ __forceinline__ f32x4 mfma16(bf16x8 a, bf16x8 b, f32x4 c) { return __builtin_amdgcn_mfma_f32_16x16x32_bf16(a, b, c, 0, 0, 0); }
__device__ __forceinline__ f32x16 mfma32(bf16x8 a, bf16x8 b, f32x16 c) { return __builtin_amdgcn_mfma_f32_32x32x16_bf16(a, b, c, 0, 0, 0); }

__device__ __forceinline__ void gla_block(LAS unsigned char* lds, int bh, const bf16_t* P0, const bf16_t* LO, const float* gla_g, bf16_t* MIX, int tid) {
    const int b = bh >> 2, h = bh & 3, lane = tid & 63, w = tid >> 6, g4 = lane >> 4, c16 = lane & 15;
    LAS bf16_t* QT = (LAS bf16_t*)lds;
    LAS bf16_t* KT = QT + 64 * 72;
    LAS bf16_t* KH = KT + 64 * 72;
    LAS bf16_t* VT = KH + 64 * 72;
    LAS bf16_t* PP = VT + 128 * 72;
    LAS float* DD = (LAS float*)(PP + 64 * 72);
    LAS float* CS = DD + 64;
    LAS float* SS = CS + 512;
    LAS float* RS = SS + 512;
    f32x4 S[4];
#pragma unroll
    for (int i = 0; i < 4; ++i) S[i] = (f32x4){0.f, 0.f, 0.f, 0.f};
    const float gg = gla_g[16 * w + c16];
    for (int ch = 0; ch < 64; ++ch) {
        const size_t row0 = (size_t)b * T + ch * 64;
        {
            const int seg = w, k = lane;
            float cum[8], qv[8], kv[8]; float cs = 0.f;
#pragma unroll
            for (int i = 0; i < 8; ++i) { const size_t r = row0 + seg * 8 + i; cs += bf2f(LO[r * LOW + 1536 + h * 64 + k]); cum[i] = cs;
                qv[i] = bf2f(P0[r * P0W + h * 64 + k]); kv[i] = bf2f(P0[r * P0W + 256 + h * 64 + k]); }
            CS[seg * 64 + k] = cs;
            const int s = tid >> 3, vg = tid & 7;
            const u32x4* vp = (const u32x4*)(P0 + (row0 + s) * P0W + 512 + h * 128 + vg * 16);
            const u32x4 v0 = vp[0], v1 = vp[1];
            BLOCK_SYNC();
            float pre = 0.f, tot = 0.f;
#pragma unroll
            for (int s2 = 0; s2 < 8; ++s2) { const float v = CS[s2 * 64 + k]; tot += v; if (s2 < seg) pre += v; }
#pragma unroll
            for (int i = 0; i < 8; ++i) { const float bb = pre + cum[i]; const int t = seg * 8 + i;
                QT[t * 72 + k] = f2bf(qv[i] * __expf(bb) * 0.125f); KT[t * 72 + k] = f2bf(kv[i] * __expf(-bb)); KH[k * 72 + t] = f2bf(kv[i] * __expf(tot - bb)); }
            if (seg == 0) DD[k] = __expf(tot);
            const unsigned vw[8] = {v0.x, v0.y, v0.z, v0.w, v1.x, v1.y, v1.z, v1.w};
#pragma unroll
            for (int j = 0; j < 8; ++j) { VT[(vg * 16 + 2 * j) * 72 + s] = (bf16_t)(vw[j] & 0xffffu); VT[(vg * 16 + 2 * j + 1) * 72 + s] = (bf16_t)(vw[j] >> 16); }
        }
        BLOCK_SYNC();
#pragma unroll
        for (int q2 = 0; q2 < 2; ++q2) {
            const int tile = 2 * w + q2, ti = tile >> 2, si = tile & 3;
            f32x4 acc = (f32x4){0.f, 0.f, 0.f, 0.f};
            if (si <= ti) {
#pragma unroll
                for (int st = 0; st < 2; ++st) { const bf16x8 a = *(LAS bf16x8*)(QT + (16 * ti + c16) * 72 + 32 * st + 8 * g4), bb = *(LAS bf16x8*)(KT + (16 * si + c16) * 72 + 32 * st + 8 * g4); acc = mfma16(a, bb, acc); }
            }
#pragma unroll
            for (int rg = 0; rg < 4; ++rg) { const int t = 16 * ti + 4 * g4 + rg, s = 16 * si + c16; PP[t * 72 + s] = f2bf(s <= t ? acc[rg] : 0.f); }
        }
        BLOCK_SYNC();
        f32x4 O[4];
        bf16x8 vb[2];
#pragma unroll
        for (int st = 0; st < 2; ++st) vb[st] = *(LAS bf16x8*)(VT + (16 * w + c16) * 72 + 32 * st + 8 * g4);
        bf16x8 sf[2];
#pragma unroll
        for (int s2 = 0; s2 < 2; ++s2) { u32x4 t4; t4.x = pk_bf16(S[2 * s2][0], S[2 * s2][1]); t4.y = pk_bf16(S[2 * s2][2], S[2 * s2][3]); t4.z = pk_bf16(S[2 * s2 + 1][0], S[2 * s2 + 1][1]); t4.w = pk_bf16(S[2 * s2 + 1][2], S[2 * s2 + 1][3]); sf[s2] = __builtin_bit_cast(bf16x8, t4); }
#pragma unroll
        for (int ti = 0; ti < 4; ++ti) {
            f32x4 acc = (f32x4){0.f, 0.f, 0.f, 0.f};
#pragma unroll
            for (int st = 0; st < 2; ++st) { const bf16x8 a = *(LAS bf16x8*)(PP + (16 * ti + c16) * 72 + 32 * st + 8 * g4); acc = mfma16(a, vb[st], acc); }
#pragma unroll
            for (int s2 = 0; s2 < 2; ++s2) { const u32x2 lo = *(LAS u32x2*)(QT + (16 * ti + c16) * 72 + 32 * s2 + 4 * g4), hi = *(LAS u32x2*)(QT + (16 * ti + c16) * 72 + 32 * s2 + 16 + 4 * g4);
                u32x4 t4; t4.x = lo.x; t4.y = lo.y; t4.z = hi.x; t4.w = hi.y; acc = mfma16(__builtin_bit_cast(bf16x8, t4), sf[s2], acc); }
            O[ti] = acc;
        }
#pragma unroll
        for (int kt = 0; kt < 4; ++kt) {
            const f32x4 dv = *(LAS f32x4*)(DD + 16 * kt + 4 * g4);
            f32x4 acc = S[kt] * dv;
#pragma unroll
            for (int st = 0; st < 2; ++st) { const bf16x8 a = *(LAS bf16x8*)(KH + (16 * kt + c16) * 72 + 32 * st + 8 * g4); acc = mfma16(a, vb[st], acc); }
            S[kt] = acc;
        }
#pragma unroll
        for (int ti = 0; ti < 4; ++ti)
#pragma unroll
            for (int rg = 0; rg < 4; ++rg) { const float q = red16(O[ti][rg] * O[ti][rg]); if (c16 == 0) SS[w * 64 + 16 * ti + 4 * g4 + rg] = q; }
        BLOCK_SYNC();
        if (tid < 64) { float s = 0.f;
#pragma unroll
            for (int w2 = 0; w2 < 8; ++w2) s += SS[w2 * 64 + tid]; RS[tid] = rsqrtf(s * (1.f / 128.f) + EPS); }
        BLOCK_SYNC();
#pragma unroll
        for (int ti = 0; ti < 4; ++ti)
#pragma unroll
            for (int rg = 0; rg < 4; ++rg) { const int t = 16 * ti + 4 * g4 + rg; const size_t r = row0 + t; const int v = 16 * w + c16;
                const float og = bf2f(P0[r * P0W + 1024 + h * 128 + v]);
                MIX[r * D + h * 128 + v] = f2bf(O[ti][rg] * RS[t] * gg * fsilu(og)); }
    }
}

__device__ __forceinline__ void rwkv_block(LAS unsigned char* lds, int unit, const bf16_t* P0, const bf16_t* LO, const float* mu, const float* k_k, const float* k_a, const float* r_k, float* Y, float* BON, int tid) {
    const int b = unit >> 4, h = (unit >> 1) & 7, half = unit & 1;
    const int row = tid >> 4, sub = tid & 15, c0 = h * 64 + 4 * sub;
    constexpr int BUFB = 45056;
    LAS float* Yb = (LAS float*)(lds + 2 * BUFB);
    float mr[4], mkk[4], mv[4], kk_[4], ka_[4], rk_[4];
#pragma unroll
    for (int e = 0; e < 4; ++e) { mr[e] = mu[c0 + e]; mkk[e] = mu[576 + c0 + e]; mv[e] = mu[1088 + c0 + e]; kk_[e] = k_k[c0 + e]; ka_[e] = k_a[c0 + e]; rk_[e] = r_k[c0 + e]; }
    u32x2 Lr, Lk, Lv, Lrp, Lkp, Lvp, Llw, La;
    auto prep_load = [&](int tc) {
        const int t = tc * 32 + row; const size_t gr = (size_t)b * T + t;
        const bf16_t* p = P0 + gr * P0W + 1552 + c0;
        Lr = *(const u32x2*)p; Lk = *(const u32x2*)(p + 576); Lv = *(const u32x2*)(p + 1088);
        if (t > 0) { Lrp = *(const u32x2*)(p - P0W); Lkp = *(const u32x2*)(p - P0W + 576); Lvp = *(const u32x2*)(p - P0W + 1088); } else { Lrp = (u32x2){0u, 0u}; Lkp = Lrp; Lvp = Lrp; }
        Llw = *(const u32x2*)(LO + gr * LOW + c0); La = *(const u32x2*)(LO + gr * LOW + 512 + c0);
    };
    auto prep_store = [&](int tc, int bufi) {
        LAS float* Wb = (LAS float*)(lds + bufi * BUFB);
        const float r4[4] = {lo_bf(Lr.x), hi_bf(Lr.x), lo_bf(Lr.y), hi_bf(Lr.y)}, rp[4] = {lo_bf(Lrp.x), hi_bf(Lrp.x), lo_bf(Lrp.y), hi_bf(Lrp.y)};
        const float k4[4] = {lo_bf(Lk.x), hi_bf(Lk.x), lo_bf(Lk.y), hi_bf(Lk.y)}, kp[4] = {lo_bf(Lkp.x), hi_bf(Lkp.x), lo_bf(Lkp.y), hi_bf(Lkp.y)};
        const float v4[4] = {lo_bf(Lv.x), hi_bf(Lv.x), lo_bf(Lv.y), hi_bf(Lv.y)}, vp[4] = {lo_bf(Lvp.x), hi_bf(Lvp.x), lo_bf(Lvp.y), hi_bf(Lvp.y)};
        const float lw[4] = {lo_bf(Llw.x), hi_bf(Llw.x), lo_bf(Llw.y), hi_bf(Llw.y)}, av[4] = {lo_bf(La.x), hi_bf(La.x), lo_bf(La.y), hi_bf(La.y)};
        f32x4 ow, okk, oka, ok2, orr, ov; float n2 = 0.f, bsum = 0.f; float kr[4];
#pragma unroll
        for (int e = 0; e < 4; ++e) {
            const float rs = r4[e] + (rp[e] - r4[e]) * mr[e], ks = k4[e] + (kp[e] - k4[e]) * mkk[e], vs = v4[e] + (vp[e] - v4[e]) * mv[e];
            kr[e] = ks * kk_[e]; n2 += kr[e] * kr[e];
            const float k2 = ks * (1.f + (av[e] - 1.f) * ka_[e]);
            ow[e] = __expf(lw[e]); ok2[e] = k2; orr[e] = rs; ov[e] = vs; bsum += rs * k2 * rk_[e];
        }
        n2 = red16(n2); bsum = red16(bsum);
        const float inv = rsqrtf(fmaxf(n2, 1e-24f));
#pragma unroll
        for (int e = 0; e < 4; ++e) { okk[e] = kr[e] * inv; oka[e] = okk[e] * av[e]; }
        *(LAS f32x4*)(Wb + row * 64 + 4 * sub) = ow; *(LAS f32x4*)(Wb + 2048 + row * 64 + 4 * sub) = okk; *(LAS f32x4*)(Wb + 4096 + row * 64 + 4 * sub) = oka;
        *(LAS f32x4*)(Wb + 6144 + row * 64 + 4 * sub) = ok2; *(LAS f32x4*)(Wb + 8192 + row * 64 + 4 * sub) = orr;
        if ((sub >> 3) == half) *(LAS f32x4*)(Wb + 10240 + row * 32 + 4 * (sub & 7)) = ov;
        if (half == 0 && sub == 0) BON[((size_t)b * T + tc * 32 + row) * 8 + h] = bsum;
    };
    float S0 = 0.f, S1 = 0.f, S2 = 0.f, S3 = 0.f;
    prep_load(0); prep_store(0, 0);
    BLOCK_SYNC();
    for (int tc = 0; tc < 128; ++tc) {
        if (tc + 1 < 128) prep_load(tc + 1);
        const LAS float* Wb = (const LAS float*)(lds + (tc & 1) * BUFB);
#pragma unroll 4
        for (int st = 0; st < 32; ++st) {
            const f32x4 w4 = *(const LAS f32x4*)(Wb + st * 64 + 4 * sub), kk4 = *(const LAS f32x4*)(Wb + 2048 + st * 64 + 4 * sub), ka4 = *(const LAS f32x4*)(Wb + 4096 + st * 64 + 4 * sub);
            const f32x4 k24 = *(const LAS f32x4*)(Wb + 6144 + st * 64 + 4 * sub), r4 = *(const LAS f32x4*)(Wb + 8192 + st * 64 + 4 * sub);
            const float vv = Wb[10240 + st * 32 + row];
            float rem = S0 * kk4[0] + S1 * kk4[1] + S2 * kk4[2] + S3 * kk4[3];
            rem = red16(rem);
            S0 = S0 * w4[0] - rem * ka4[0] + vv * k24[0]; S1 = S1 * w4[1] - rem * ka4[1] + vv * k24[1];
            S2 = S2 * w4[2] - rem * ka4[2] + vv * k24[2]; S3 = S3 * w4[3] - rem * ka4[3] + vv * k24[3];
            float y = S0 * r4[0] + S1 * r4[1] + S2 * r4[2] + S3 * r4[3];
            y = red16(y);
            if (sub == 0) Yb[st * 32 + row] = y;
        }
        BLOCK_SYNC();
#pragma unroll
        for (int i = 0; i < 2; ++i) { const int tt = (tid >> 5) + 16 * i, rr = tid & 31; Y[((size_t)b * T + tc * 32 + tt) * 512 + h * 64 + 32 * half + rr] = Yb[tt * 32 + rr]; }
        if (tc + 1 < 128) prep_store(tc + 1, (tc + 1) & 1);
        BLOCK_SYNC();
    }
}

__device__ __forceinline__ void rwkv_out_phase(const float* Y, const float* BON, const bf16_t* P0, const bf16_t* LO, const float* mu, const float* gn_w, const float* gn_b, bf16_t* MIX, int gtid, int NT) {
    for (int task = gtid; task < M * 128; task += NT) {
        const int m = task >> 7, h = (task >> 4) & 7, sub = task & 15, c0 = h * 64 + 4 * sub;
        const f32x4 y = *(const f32x4*)(Y + (size_t)m * 512 + c0);
        const float mean = red16((y[0] + y[1]) + (y[2] + y[3])) * (1.f / 64.f);
        const f32x4 dv = y - mean;
        const float var = red16((dv[0] * dv[0] + dv[1] * dv[1]) + (dv[2] * dv[2] + dv[3] * dv[3])) * (1.f / 64.f);
        const float rstd = rsqrtf(var + 64e-5f);
        const bf16_t* p = P0 + (size_t)m * P0W + 1552 + 1088 + c0;
        const u32x2 vc = *(const u32x2*)p; u32x2 vpv = (u32x2){0u, 0u}; if ((m & (T - 1)) != 0) vpv = *(const u32x2*)(p - P0W);
        const float v4[4] = {lo_bf(vc.x), hi_bf(vc.x), lo_bf(vc.y), hi_bf(vc.y)}, vp[4] = {lo_bf(vpv.x), hi_bf(vpv.x), lo_bf(vpv.y), hi_bf(vpv.y)};
        const u32x2 gq = *(const u32x2*)(LO + (size_t)m * LOW + 1024 + c0);
        const float g4[4] = {lo_bf(gq.x), hi_bf(gq.x), lo_bf(gq.y), hi_bf(gq.y)};
        const float bon = BON[(size_t)m * 8 + h];
        float o[4];
#pragma unroll
        for (int e = 0; e < 4; ++e) { const float vs = v4[e] + (vp[e] - v4[e]) * mu[1088 + c0 + e]; o[e] = (dv[e] * rstd * gn_w[c0 + e] + gn_b[c0 + e] + bon * vs) * g4[e]; }
        u32x2 w; w.x = pk_bf16(o[0], o[1]); w.y = pk_bf16(o[2], o[3]);
        *(u32x2*)(MIX + (size_t)m * D + 512 + c0) = w;
    }
}

__device__ __forceinline__ void compress_unit(LAS unsigned char* lds, int u, const bf16_t* P1, const bf16_t* W1T, const float* cbias, const float* w2k, const float* w2v, bf16_t* CMPK, bf16_t* CMPVT, int tid) {
    const int which = u >> 8, b = (u >> 6) & 3, g = (u >> 4) & 3, nb = u & 15, n0 = nb * 16;
    const int lane = tid & 63, w = tid >> 6, g4 = lane >> 4, c16 = lane & 15;
    LAS float* PART = (LAS float*)lds;
    LAS float* HID = PART + 8 * 16 * 64;
    f32x4 acc[4];
#pragma unroll
    for (int j = 0; j < 4; ++j) acc[j] = (f32x4){0.f, 0.f, 0.f, 0.f};
    const int n = n0 + c16; const bool valid = n < 255;
    const bf16_t* abase = P1 + ((size_t)b * T + 16 * (valid ? n : 0)) * P1W + 1024 + which * 256 + g * 64;
    const bf16_t* wbase = W1T + (size_t)which * 64 * 2048;
#pragma unroll
    for (int i = 0; i < 8; ++i) {
        const int ks = 8 * w + i, li = ks >> 1, d0 = 32 * (ks & 1) + 8 * g4;
        bf16x8 a = (bf16x8){0, 0, 0, 0, 0, 0, 0, 0};
        if (valid) a = *(const bf16x8*)(abase + (size_t)li * P1W + d0);
#pragma unroll
        for (int jt = 0; jt < 4; ++jt) { const bf16x8 bb = *(const bf16x8*)(wbase + (size_t)(16 * jt + c16) * 2048 + 32 * ks + 8 * g4); acc[jt] = mfma16(a, bb, acc[jt]); }
    }
#pragma unroll
    for (int jt = 0; jt < 4; ++jt)
#pragma unroll
        for (int rg = 0; rg < 4; ++rg) PART[(w * 16 + 4 * g4 + rg) * 64 + 16 * jt + c16] = acc[jt][rg];
    BLOCK_SYNC();
    {
        const int nn = tid >> 5, j2 = (tid & 31) * 2;
        float s0 = cbias[which * 64 + j2], s1 = cbias[which * 64 + j2 + 1];
#pragma unroll
        for (int w2 = 0; w2 < 8; ++w2) { s0 += PART[(w2 * 16 + nn) * 64 + j2]; s1 += PART[(w2 * 16 + nn) * 64 + j2 + 1]; }
        HID[nn * 64 + j2] = fgelu(s0); HID[nn * 64 + j2 + 1] = fgelu(s1);
    }
    BLOCK_SYNC();
    {
        const int nn = tid >> 5, d2 = (tid & 31) * 2; const float* w2 = which ? w2v : w2k;
        float o0 = 0.f, o1 = 0.f;
#pragma unroll 8
        for (int j = 0; j < 64; ++j) { const float hv = HID[nn * 64 + j]; o0 += hv * w2[j * 64 + d2]; o1 += hv * w2[j * 64 + d2 + 1]; }
        const int ng = n0 + nn; if (ng >= 255) { o0 = 0.f; o1 = 0.f; }
        if (which == 0) *(unsigned*)(CMPK + (((size_t)b * 4 + g) * 256 + ng) * 64 + d2) = pk_bf16(o0, o1);
        else { CMPVT[(((size_t)b * 4 + g) * 64 + d2) * 256 + ng] = f2bf(o0); CMPVT[(((size_t)b * 4 + g) * 64 + d2 + 1) * 256 + ng] = f2bf(o1); }
    }
    BLOCK_SYNC();
}
__device__ __forceinline__ void vtrans_item(LAS bf16_t* scr  , int it, const bf16_t* P1, bf16_t* VTS, bf16_t* VTW, int lane) {
    const int which = it >> 10, b = (it >> 8) & 3, g = (it >> 6) & 3, tt = it & 63;
    const bf16_t* src = P1 + ((size_t)b * T + tt * 64) * P1W + (which ? 2304 : 1792) + g * 64;
    bf16_t* dst = (which ? VTW : VTS) + (((size_t)b * 4 + g) * 64) * T + tt * 64;
#pragma unroll
    for (int i = 0; i < 8; ++i) { const int t = (lane >> 3) + 8 * i, ch = lane & 7; const u32x4 v = *(const u32x4*)(src + (size_t)t * P1W + ch * 8);
        LAS unsigned* d = (LAS unsigned*)(scr + t * 66 + ch * 8); d[0] = v.x; d[1] = v.y; d[2] = v.z; d[3] = v.w; }
    LDS_WAIT(); asm volatile("" ::: "memory");
#pragma unroll
    for (int i = 0; i < 8; ++i) { const int d = (lane >> 3) + 8 * i, t0 = (lane & 7) * 8;
        unsigned short e[8];
#pragma unroll
        for (int j = 0; j < 8; ++j) e[j] = scr[(t0 + j) * 66 + d];
        u32x4 o; o.x = e[0] | ((unsigned)e[1] << 16); o.y = e[2] | ((unsigned)e[3] << 16); o.z = e[4] | ((unsigned)e[5] << 16); o.w = e[6] | ((unsigned)e[7] << 16);
        *(u32x4*)(dst + (size_t)d * T + t0) = o; }
    LDS_WAIT(); asm volatile("" ::: "memory");
}

__device__ __forceinline__ int crow(int r, int hi) { return (r & 3) + 8 * (r >> 2) + 4 * hi; }
struct TileRegs { u32x4 k, v; };
__device__ __forceinline__ void tile_load(TileRegs& R, const bf16_t* kp, size_t kstride, const bf16_t* vp, size_t vstride, int tid) {
    const int ri = tid >> 3, ch = tid & 7;
    R.k = *(const u32x4*)(kp + (size_t)ri * kstride + ch * 8); R.v = *(const u32x4*)(vp + (size_t)ri * vstride + ch * 8);
}
__device__ __forceinline__ void tile_store(const TileRegs& R, LAS bf16_t* KB, LAS bf16_t* VB, int tid) {
    const int ri = tid >> 3, ch = tid & 7;
    *(LAS u32x4*)(KB + ri * 72 + ch * 8) = R.k; *(LAS u32x4*)(VB + ri * 72 + ch * 8) = R.v;
}
template <int MODE>
__device__ __forceinline__ void attn_tile(const LAS bf16_t* KB, const LAS bf16_t* VB, const bf16x8 (&qf)[4], f32x16& o0, f32x16& o1, float& m, float& l,
                                          int tq, int kbase, float slope2, bool selbit, float invl, LAS float* imp_row, int jbase, int hq, int hh) {
    f32x16 p0, p1;
#pragma unroll
    for (int r = 0; r < 16; ++r) { p0[r] = 0.f; p1[r] = 0.f; }
#pragma unroll
    for (int s = 0; s < 4; ++s) {
        const bf16x8 a0 = *(const LAS bf16x8*)(KB + hq * 72 + 16 * s + 8 * hh), a1 = *(const LAS bf16x8*)(KB + (32 + hq) * 72 + 16 * s + 8 * hh);
        p0 = mfma32(a0, qf[s], p0); p1 = mfma32(a1, qf[s], p1);
    }
    constexpr float C1 = 0.125f * LOG2E;
    const float NEG = -INFINITY;
    float mx = NEG;
#pragma unroll
    for (int r = 0; r < 16; ++r) {
        const int kr = crow(r, hh);
        int d0, d1; bool v0, v1;
        if (MODE <= 1) { d0 = tq - 31 - 16 * (kbase + kr); d1 = d0 - 512; v0 = d0 >= 0; v1 = d1 >= 0; }
        else { d0 = tq - (kbase + kr); d1 = d0 - 32; if (MODE == 2) { v0 = selbit && d0 >= 0; v1 = selbit && d1 >= 0; } else { v0 = d0 >= 0 && d0 < 512; v1 = d1 >= 0 && d1 < 512; } }
        p0[r] = v0 ? p0[r] * C1 - slope2 * (float)d0 : NEG;
        p1[r] = v1 ? p1[r] * C1 - slope2 * (float)d1 : NEG;
        mx = fmaxf(mx, fmaxf(p0[r], p1[r]));
    }
    if (MODE == 1) {
        float sums[8];
#pragma unroll
        for (int r = 0; r < 16; ++r) { p0[r] = __builtin_amdgcn_exp2f(p0[r] - m) * invl; p1[r] = __builtin_amdgcn_exp2f(p1[r] - m) * invl; }
#pragma unroll
        for (int q4 = 0; q4 < 4; ++q4) { sums[q4] = (p0[4 * q4] + p0[4 * q4 + 1]) + (p0[4 * q4 + 2] + p0[4 * q4 + 3]); sums[4 + q4] = (p1[4 * q4] + p1[4 * q4 + 1]) + (p1[4 * q4 + 2] + p1[4 * q4 + 3]); }
#pragma unroll
        for (int q4 = 0; q4 < 4; ++q4) {
            const int j0 = jbase + 2 * q4 + hh, j1 = j0 + 8;
            atomicAdd((float*)(imp_row + j0), sums[q4]); if (j0 + 1 < 64) atomicAdd((float*)(imp_row + j0 + 1), p0[4 * q4 + 3]);
            atomicAdd((float*)(imp_row + j1), sums[4 + q4]); if (j1 + 1 < 64) atomicAdd((float*)(imp_row + j1 + 1), p1[4 * q4 + 3]);
        }
    } else {
        mx = fmaxf(mx, __shfl_xor(mx, 32));
        const float mn = fmaxf(m, mx);
        const float ms = (mn == NEG) ? 0.f : mn;
        const float alpha = __builtin_amdgcn_exp2f(m - ms);
        float ps = 0.f;
#pragma unroll
        for (int r = 0; r < 16; ++r) { p0[r] = __builtin_amdgcn_exp2f(p0[r] - ms); p1[r] = __builtin_amdgcn_exp2f(p1[r] - ms); ps += p0[r] + p1[r]; }
        l = l * alpha + ps; m = mn;
        if (MODE == 0) return;
#pragma unroll
        for (int r = 0; r < 16; ++r) { o0[r] *= alpha; o1[r] *= alpha; }
    }
#pragma unroll
    for (int ks = 0; ks < 4; ++ks) {
        u32x4 pk;
        if (ks < 2) { pk.x = pk_bf16(p0[8 * ks], p0[8 * ks + 1]); pk.y = pk_bf16(p0[8 * ks + 2], p0[8 * ks + 3]); pk.z = pk_bf16(p0[8 * ks + 4], p0[8 * ks + 5]); pk.w = pk_bf16(p0[8 * ks + 6], p0[8 * ks + 7]); }
        else { const int k2 = ks - 2; pk.x = pk_bf16(p1[8 * k2], p1[8 * k2 + 1]); pk.y = pk_bf16(p1[8 * k2 + 2], p1[8 * k2 + 3]); pk.z = pk_bf16(p1[8 * k2 + 4], p1[8 * k2 + 5]); pk.w = pk_bf16(p1[8 * k2 + 6], p1[8 * k2 + 7]); }
        const bf16x8 pf = __builtin_bit_cast(bf16x8, pk);
        const int koff = 32 * (ks >> 1) + 16 * (ks & 1) + 4 * hh;
#pragma unroll
        for (int dt = 0; dt < 2; ++dt) {
            const u32x2 lo = *(const LAS u32x2*)(VB + (32 * dt + hq) * 72 + koff), hi = *(const LAS u32x2*)(VB + (32 * dt + hq) * 72 + koff + 8);
            u32x4 a4; a4.x = lo.x; a4.y = lo.y; a4.z = hi.x; a4.w = hi.y;
            if (dt == 0) o0 = mfma32(__builtin_bit_cast(bf16x8, a4), pf, o0); else o1 = mfma32(__builtin_bit_cast(bf16x8, a4), pf, o1);
        }
    }
}

__device__ __forceinline__ void nsa_unit(LAS unsigned char* lds, int b, int g, int qt, const bf16_t* P1, const bf16_t* CMPK, const bf16_t* CMPVT, const bf16_t* VTS, const bf16_t* VTW, bf16_t* OUT, int tid) {
    const int lane = tid & 63, w = tid >> 6, r = w >> 1, th = w & 1, hq = lane & 31, hh = lane >> 5;
    const int h = g * 4 + r, q0 = qt * 64, tokl = 32 * th + hq, tq = q0 + tokl;
    const size_t grow = (size_t)b * T + tq;
    LAS bf16_t* KB0 = (LAS bf16_t*)lds; LAS bf16_t* VB0 = KB0 + 2 * 64 * 72;
    LAS float* IMP = (LAS float*)(lds + 36864);
    LAS unsigned* SELM = (LAS unsigned*)(lds + 36864 + 66560);
    LAS unsigned* UNI = SELM + 128;
    const float slope2 = exp2f(-0.5f * (float)(h + 1)) * LOG2E;
    bf16x8 qf[4];
#pragma unroll
    for (int s = 0; s < 4; ++s) qf[s] = *(const bf16x8*)(P1 + grow * P1W + h * 64 + 16 * s + 8 * hh);
    const bf16_t* gp = P1 + grow * P1W + 2560 + h * 3;
    const float gate0 = fsigmoid(bf2f(gp[0])), gate1 = fsigmoid(bf2f(gp[1])), gate2 = fsigmoid(bf2f(gp[2]));
    for (int i = tid; i < 4 * 64 * 65; i += NTHREADS) IMP[i] = 0.f;
    if (tid < 2) UNI[tid] = 0u;
    f32x16 oa0, oa1;
#pragma unroll
    for (int i = 0; i < 16; ++i) { oa0[i] = 0.f; oa1[i] = 0.f; }
    TileRegs R;
    const size_t bg = (size_t)b * 4 + g;
    const int nmax = (q0 + 63 - 31) / 16;
    const int nct = nmax / 64 + 1;
    float cm = -INFINITY, cl = 0.f;
    f32x16 o0, o1;
    for (int pass = 0; pass < 2; ++pass) {
#pragma unroll
        for (int i = 0; i < 16; ++i) { o0[i] = 0.f; o1[i] = 0.f; }
        float invl = 0.f;
        if (pass == 1) { const float lt = cl + __shfl_xor(cl, 32); invl = lt > 0.f ? 1.f / lt : 0.f; if (cm == -INFINITY) cm = 0.f; }
        tile_load(R, CMPK + bg * 256 * 64, 64, CMPVT + bg * 64 * 256, 256, tid);
        BLOCK_SYNC();
        tile_store(R, KB0, VB0, tid);
        BLOCK_SYNC();
        for (int ct = 0; ct < nct; ++ct) {
            if (ct + 1 < nct) tile_load(R, CMPK + (bg * 256 + 64 * (ct + 1)) * 64, 64, CMPVT + bg * 64 * 256 + 64 * (ct + 1), 256, tid);
            const LAS bf16_t* KB = KB0 + (ct & 1) * 64 * 72; const LAS bf16_t* VB = VB0 + (ct & 1) * 64 * 72;
            if (pass == 0) attn_tile<0>(KB, VB, qf, o0, o1, cm, cl, tq, 64 * ct, slope2, true, 0.f, nullptr, 0, hq, hh);
            else attn_tile<1>(KB, VB, qf, o0, o1, cm, cl, tq, 64 * ct, slope2, true, invl, IMP + (r * 64 + tokl) * 65, 16 * ct, hq, hh);
            if (ct + 1 < nct) tile_store(R, KB0 + ((ct + 1) & 1) * 64 * 72, VB0 + ((ct + 1) & 1) * 64 * 72, tid);
            BLOCK_SYNC();
        }
    }
#pragma unroll
    for (int i = 0; i < 16; ++i) { oa0[i] += gate0 * o0[i]; oa1[i] += gate0 * o1[i]; }
    {
        const int tok = tid >> 3, part = tid & 7;
        float sc[8];
#pragma unroll
        for (int jj = 0; jj < 8; ++jj) { const int j = 8 * part + jj;
            const float im = ((IMP[(0 * 64 + tok) * 65 + j] + IMP[(1 * 64 + tok) * 65 + j]) + IMP[(2 * 64 + tok) * 65 + j]) + IMP[(3 * 64 + tok) * 65 + j];
            const bool valid = j <= qt; const bool forced = (j == 0) || (valid && (qt - j) < 2);
            sc[jj] = valid ? im + (forced ? 100.f : 0.f) : -100.f; }
        unsigned mlo = 0u, mhi = 0u;
        for (int it = 0; it < 8; ++it) {
            float bv = sc[0]; int bj = 0;
#pragma unroll
            for (int jj = 1; jj < 8; ++jj) if (sc[jj] > bv) { bv = sc[jj]; bj = jj; }
            bj += 8 * part;
#pragma unroll
            for (int o = 1; o < 8; o <<= 1) { const float ov = __shfl_xor(bv, o); const int oj = __shfl_xor(bj, o); if (ov > bv || (ov == bv && oj < bj)) { bv = ov; bj = oj; } }
            if ((bj >> 3) == part) {
#pragma unroll
                for (int jj = 0; jj < 8; ++jj) if (jj == (bj & 7)) sc[jj] = -INFINITY;
            }
            if (bj <= qt) { if (bj < 32) mlo |= 1u << bj; else mhi |= 1u << (bj - 32); }
        }
        if (part == 0) { SELM[tok * 2] = mlo; SELM[tok * 2 + 1] = mhi; atomicOr((unsigned*)(UNI), mlo); atomicOr((unsigned*)(UNI + 1), mhi); }
    }
    BLOCK_SYNC();
    const unsigned mylo = SELM[tokl * 2], myhi = SELM[tokl * 2 + 1];
    unsigned long long uni = ((unsigned long long)UNI[1] << 32) | UNI[0];
    uni = ((unsigned long long)__builtin_amdgcn_readfirstlane((unsigned)(uni >> 32)) << 32) | (unsigned)__builtin_amdgcn_readfirstlane((unsigned)uni);
    {
        float sm = -INFINITY, sl = 0.f;
#pragma unroll
        for (int i = 0; i < 16; ++i) { o0[i] = 0.f; o1[i] = 0.f; }
        const bf16_t* kcol = P1 + (size_t)b * T * P1W + 1536 + g * 64; const bf16_t* vrow = VTS + bg * 64 * T;
        unsigned long long rem = uni;
        int j = __builtin_ctzll(rem); rem &= rem - 1;
        tile_load(R, kcol + (size_t)64 * j * P1W, P1W, vrow + 64 * j, T, tid);
        tile_store(R, KB0, VB0, tid);
        BLOCK_SYNC();
        int pb = 0;
        for (;;) {
            const bool more = rem != 0ull; int jn = 0;
            if (more) { jn = __builtin_ctzll(rem); rem &= rem - 1; tile_load(R, kcol + (size_t)64 * jn * P1W, P1W, vrow + 64 * jn, T, tid); }
            const bool sb = j < 32 ? ((mylo >> j) & 1u) : ((myhi >> (j - 32)) & 1u);
            attn_tile<2>(KB0 + pb * 64 * 72, VB0 + pb * 64 * 72, qf, o0, o1, sm, sl, tq, 64 * j, slope2, sb, 0.f, nullptr, 0, hq, hh);
            if (more) tile_store(R, KB0 + (pb ^ 1) * 64 * 72, VB0 + (pb ^ 1) * 64 * 72, tid);
            BLOCK_SYNC();
            if (!more) break;
            j = jn; pb ^= 1;
        }
        const float lt = sl + __shfl_xor(sl, 32); const float sc = lt > 0.f ? gate1 / lt : 0.f;
#pragma unroll
        for (int i = 0; i < 16; ++i) { oa0[i] += sc * o0[i]; oa1[i] += sc * o1[i]; }
    }
    {
        float sm = -INFINITY, sl = 0.f;
#pragma unroll
        for (int i = 0; i < 16; ++i) { o0[i] = 0.f; o1[i] = 0.f; }
        const bf16_t* kcol = P1 + (size_t)b * T * P1W + 2048 + g * 64; const bf16_t* vrow = VTW + bg * 64 * T;
        const int jlo = qt >= 8 ? qt - 8 : 0;
        tile_load(R, kcol + (size_t)64 * jlo * P1W, P1W, vrow + 64 * jlo, T, tid);
        tile_store(R, KB0, VB0, tid);
        BLOCK_SYNC();
        for (int j = jlo; j <= qt; ++j) {
            const int pb = (j - jlo) & 1;
            if (j < qt) tile_load(R, kcol + (size_t)64 * (j + 1) * P1W, P1W, vrow + 64 * (j + 1), T, tid);
            attn_tile<3>(KB0 + pb * 64 * 72, VB0 + pb * 64 * 72, qf, o0, o1, sm, sl, tq, 64 * j, slope2, true, 0.f, nullptr, 0, hq, hh);
            if (j < qt) tile_store(R, KB0 + (pb ^ 1) * 64 * 72, VB0 + (pb ^ 1) * 64 * 72, tid);
            BLOCK_SYNC();
        }
        const float lt = sl + __shfl_xor(sl, 32); const float sc = lt > 0.f ? gate2 / lt : 0.f;
#pragma unroll
        for (int i = 0; i < 16; ++i) { oa0[i] += sc * o0[i]; oa1[i] += sc * o1[i]; }
    }
    bf16_t* op = OUT + grow * D + h * 64;
#pragma unroll
    for (int q4 = 0; q4 < 4; ++q4) {
        u32x2 w0; w0.x = pk_bf16(oa0[4 * q4], oa0[4 * q4 + 1]); w0.y = pk_bf16(oa0[4 * q4 + 2], oa0[4 * q4 + 3]);
        u32x2 w1; w1.x = pk_bf16(oa1[4 * q4], oa1[4 * q4 + 1]); w1.y = pk_bf16(oa1[4 * q4 + 2], oa1[4 * q4 + 3]);
        *(u32x2*)(op + 8 * q4 + 4 * hh) = w0; *(u32x2*)(op + 32 + 8 * q4 + 4 * hh) = w1;
    }
    BLOCK_SYNC();
}


#ifndef STOP_AFTER
#define STOP_AFTER (-1)
#endif
constexpr size_t WS_HASH = 246 * MiB;
__device__ __forceinline__ void dbg_hash_region(const unsigned char* base, size_t nbytes, unsigned* HB, int gtid, int NT, bool first) {
    const unsigned* p = (const unsigned*)base; const size_t nw = nbytes / 4;
    for (int i = gtid; i < (1 << 20); i += NT) { unsigned h = first ? 0u : HB[i]; for (size_t j = i; j < nw; j += (1u << 20)) h = h * 31u + p[j]; HB[i] = h; }
}
#define DBG_STOP(k, b0, n0, b1, n1) do { if (STOP_AFTER == (k)) { const int gt_ = bid * NTHREADS + (int)threadIdx.x, NT_ = G * NTHREADS; unsigned* HB_ = (unsigned*)(ws + WS_HASH); \
        if ((n0) > 0) dbg_hash_region((const unsigned char*)(b0), (n0), HB_, gt_, NT_, true); if ((n1) > 0) dbg_hash_region((const unsigned char*)(b1), (n1), HB_, gt_, NT_, false); \
        grid.sync(); if ((n0) > 0) for (int i_ = gt_; i_ < M * D; i_ += NT_) P.out[i_] = (float)(HB_[i_ & ((1 << 20) - 1)] & 0xfffffu); return; } } while (0)

__global__ void __launch_bounds__(NTHREADS, 2) mega_fwd(Ptrs P) {
    extern __shared__ __attribute__((aligned(16))) unsigned char lds_raw[];
    LAS unsigned char* lds = (LAS unsigned char*)lds_raw;
    cg::grid_group grid = cg::this_grid();
    const int bid = blockIdx.x, G = gridDim.x, NGW = G * NWAVES;
#define TIDS() int tid = threadIdx.x; asm volatile("" : "+v"(tid)); const int lane = tid & 63, wave = __builtin_amdgcn_readfirstlane(tid >> 6), gw = bid * NWAVES + wave; (void)lane; (void)gw;
    unsigned char* ws = P.ws;
    const float* x = P.in[0];
    float* X = P.out;
    float* MOD = (float*)(ws + WS_MOD);
    bf16_t* HN = (bf16_t*)(ws + WS_HN); bf16_t* MIX = HN;
    bf16_t* P0 = (bf16_t*)(ws + WS_P0); bf16_t* LI = (bf16_t*)(ws + WS_LI); bf16_t* LO = (bf16_t*)P.out;
    float* Y = (float*)(ws + WS_Y); float* BON = (float*)(ws + WS_BON);
    bf16_t* H = (bf16_t*)(ws + WS_H); bf16_t* P1 = (bf16_t*)(ws + WS_P1);
    bf16_t* VTS = (bf16_t*)(ws + WS_VTS); bf16_t* VTW = (bf16_t*)(ws + WS_VTW); bf16_t* CMPK = (bf16_t*)(ws + WS_CMPK); bf16_t* CMPVT = (bf16_t*)(ws + WS_CMPVT);
#define GRID_SYNC() do { asm volatile("s_waitcnt vmcnt(0) lgkmcnt(0)" ::: "memory"); grid.sync(); } while (0)
#ifndef PHMASK
#define PHMASK 0xffffffffu
#endif
#define PH(n) (((PHMASK) >> (n)) & 1u)
#define GEMM(EpiT, E, Aptr, Bptr, Mrows, Ncols, Kdim, arows, nMt) do { pg8::Gemm g_{(Aptr), (Bptr), (Mrows), (Ncols), (Kdim), (arows)}; pg8::StaticOrder S_; S_.init_tiles((nMt), (Ncols) / 256, G, bid); \
        pg8::gemm_phase<EpiT, pg8::StaticOrder, true, true>(lds, g_, S_, (E)); } while (0)

    { TIDS();
    if (PH(0)) prologue(P, lds, tid, lane, wave, bid, G);
    }
    GRID_SYNC(); DBG_STOP(0, ws + WS_MOD, WS_HNA - WS_MOD, ws, 0);
    { TIDS();
    if (PH(1)) norm_phase(x, P.in[4], MOD, 0, D, HN, nullptr, gw, NGW, lane);
    }
    GRID_SYNC(); DBG_STOP(1, ws + WS_HN, (size_t)M * D * 2, ws, 0);
    { TIDS();
    if (PH(2)) { EpiStore E{P0, P0W, P0W}; GEMM(EpiStore, E, HN, (const bf16_t*)(ws + WS_WEVIN), M, P0W, D, 256, 64); }
    }
    GRID_SYNC(); DBG_STOP(2, ws + WS_P0, (size_t)M * P0W * 2, ws, 0);
    { TIDS();
    if (PH(3)) lora_in_phase(P0, P.in[11], LI, gw, NGW, lane);
    }
    GRID_SYNC(); DBG_STOP(3, ws + WS_LI, (size_t)M * LIW * 2, ws, 0);
    { TIDS();
    if (PH(4)) { EpiLora E{LO, P.in[15], P.in[17], P.in[13]}; GEMM(EpiLora, E, LI, (const bf16_t*)(ws + WS_WLORA), M, LOW, LIW, 256, 64); }
    }
    GRID_SYNC(); DBG_STOP(4, (unsigned char*)P.out, (size_t)M * LOW * 2, ws, 0);
    { TIDS();
    for (int u = bid; u < 80; u += G) {
        if (u < 64) { if (PH(5)) rwkv_block(lds, u, P0, LO, P.in[11], P.in[20], P.in[21], P.in[22], Y, BON, tid); }
        else if (PH(6)) gla_block(lds, u - 64, P0, LO, P.in[14], MIX, tid);
        BLOCK_SYNC();
    } }
    GRID_SYNC(); DBG_STOP(5, ws + WS_Y, (size_t)M * 512 * 4 + (size_t)M * 8 * 4, ws + WS_HN, (size_t)M * D * 2);
    { TIDS();
    if (PH(7)) rwkv_out_phase(Y, BON, P0, LO, P.in[11], P.in[23], P.in[24], MIX, bid * NTHREADS + tid, G * NTHREADS);
    }
    GRID_SYNC(); DBG_STOP(6, ws + WS_HN, (size_t)M * D * 2, ws, 0);
    { TIDS();
    if (PH(8)) { EpiRes E{x, X, MOD + 2 * D}; GEMM(EpiRes, E, MIX, (const bf16_t*)(ws + WS_WEVOUT), M, D, D, 256, 64); }
    }
    GRID_SYNC(); DBG_STOP(7, ws, 0, ws, 0);
    for (int layer = 0; layer < 2; ++layer) {
        const float* modl = MOD + (size_t)layer * NB * 6144;
        if (layer == 1) {
            { TIDS();
            if (PH(16)) norm_phase(X, P.in[4] + D, modl, 0, D, HN, nullptr, gw, NGW, lane);
            }
            GRID_SYNC(); DBG_STOP(11, ws + WS_HN, (size_t)M * D * 2, ws, 0);
            { TIDS();
            if (PH(13)) { EpiStore E{P1, P1W, P1W}; GEMM(EpiStore, E, HN, (const bf16_t*)(ws + WS_WODIN), M, P1W, D, 256, 64); }
            }
            GRID_SYNC(); DBG_STOP(12, ws + WS_P1, (size_t)M * P1W * 2, ws, 0);
            { TIDS();
            if (PH(9)) for (int u = bid; u < 512; u += G) compress_unit(lds, u, P1, (const bf16_t*)(ws + WS_W1T), (const float*)(ws + WS_CBIAS), P.in[29], P.in[32], CMPK, CMPVT, tid);
            }
            { TIDS();
            if (PH(10)) for (int it = gw; it < 2048; it += NGW) vtrans_item((LAS bf16_t*)(lds + 40960 + wave * 8448), it, P1, VTS, VTW, lane);
            }
            GRID_SYNC(); DBG_STOP(13, ws + WS_VTS, WS_CMPVT + 512 * 1024 - WS_VTS, ws, 0);
            { TIDS();
            if (PH(11)) for (int vb = bid; vb < 256; vb += G) { const int q = vb & 63, s = (vb >> 6) & 3;
              for (int i = 0; i < 4; ++i) { const int bgi = 4 * s + i; const int qq = (i & 2) ? ((q + 32) & 63) : q; const int qt = (i & 1) ? 63 - qq : qq;
                  nsa_unit(lds, bgi >> 2, bgi & 3, qt, P1, CMPK, CMPVT, VTS, VTW, MIX, tid); } }
            }
            GRID_SYNC(); DBG_STOP(14, ws + WS_HN, (size_t)M * D * 2, ws, 0);
            { TIDS();
            if (PH(14)) { EpiRes E{X, X, modl + 2 * D}; GEMM(EpiRes, E, MIX, (const bf16_t*)(ws + WS_WODOUT), M, D, D, 256, 64); }
            }
            GRID_SYNC(); DBG_STOP(15, ws, 0, ws, 0);
        }
        { TIDS();
        if (PH(16)) norm_phase(X, P.in[5] + layer * D, modl, 3 * D, 4 * D, HN, nullptr, gw, NGW, lane);
        }
        GRID_SYNC(); DBG_STOP(8 + 8 * layer, ws + WS_HN, (size_t)M * D * 2, ws, 0);
        { TIDS();
        if (PH(12)) { EpiConv E{H, P.in[7] + (size_t)layer * 3 * F, P.in[8] + (size_t)layer * F, (LAS float*)(lds + LDS_HALO)};
          GEMM(EpiConv, E, HN - 2 * D, (const bf16_t*)(ws + WS_WUP) + (size_t)layer * 2 * F * D, M, 2 * F, D, 254, 65); }
        }
        GRID_SYNC(); DBG_STOP(9 + 8 * layer, ws + WS_H, (size_t)M * F * 2, ws, 0);
        { TIDS();
        if (PH(15)) { EpiRes E{X, X, modl + 5 * D}; GEMM(EpiRes, E, H, (const bf16_t*)(ws + WS_WDN) + (size_t)layer * D * F, M, D, F, 256, 64); }
        }
        GRID_SYNC(); DBG_STOP(10 + 8 * layer, ws, 0, ws, 0);
    }
    { TIDS();
    if (PH(16)) norm_phase(X, P.in[34], nullptr, 0, 0, nullptr, X, gw, NGW, lane);
    }
}
}

extern "C" void kernel_launch(void* const* d_in, const int* in_sizes, int n_in, void* d_out, int out_size, void* d_ws, size_t ws_size, hipStream_t stream) {
    static int grid = 0;
    if (grid == 0) {
        if (n_in != 35 || ws_size < mk::WS_END) { fprintf(stderr, "kernel_launch: unexpected inputs (n_in %d, ws %zu)\n", n_in, ws_size); grid = -1; return; }
        int dev = 0, cus = 0, per_cu = 0;
        if (hipGetDevice(&dev) != hipSuccess || hipDeviceGetAttribute(&cus, hipDeviceAttributeMultiprocessorCount, dev) != hipSuccess) { grid = -1; return; }
        if (hipFuncSetAttribute((const void*)mk::mega_fwd, hipFuncAttributeMaxDynamicSharedMemorySize, mk::LDS_BYTES) != hipSuccess) { fprintf(stderr, "kernel_launch: hipFuncSetAttribute failed\n"); grid = -1; return; }
        if (hipOccupancyMaxActiveBlocksPerMultiprocessor(&per_cu, (const void*)mk::mega_fwd, mk::NTHREADS, mk::LDS_BYTES) != hipSuccess || per_cu < 1) { fprintf(stderr, "kernel_launch: occupancy query says %d\n", per_cu); grid = -1; return; }
        grid = cus;
        if (grid > 256) grid = 256;
    }
    if (grid < 0) return;
    mk::Ptrs p{};
    for (int i = 0; i < 35; ++i) p.in[i] = (const float*)d_in[i];
    p.out = (float*)d_out; p.ws = (unsigned char*)d_ws;
#ifdef EXP_MEMSET
    (void)hipMemsetAsync(d_ws, 0, mk::WS_END, stream); (void)hipMemsetAsync(d_out, 0, (size_t)out_size * 4, stream);
#endif
    void* args[] = {&p};
    hipError_t e = hipLaunchCooperativeKernel((const void*)mk::mega_fwd, dim3(grid), dim3(mk::NTHREADS), args, mk::LDS_BYTES, stream);
    if (e != hipSuccess) fprintf(stderr, "cooperative launch failed: %s (grid %d)\n", hipGetErrorString(e), grid);
}
```

```cpp
#include <hip/hip_runtime.h>
#include <hip/hip_cooperative_groups.h>
#include <cstdio>
#include <cstdint>
namespace cg = cooperative_groups;
namespace pg8 {
#define PG8_LAS __attribute__((address_space(3)))
typedef unsigned short bf16_t;
typedef short bf16x8 __attribute__((ext_vector_type(8)));
typedef float f32x4 __attribute__((ext_vector_type(4)));
typedef unsigned u32x4 __attribute__((ext_vector_type(4)));
constexpr int BM = 256, BK = 64, HALF = 128, HTB = HALF * BK * 2  , STAGE_BYTES = 8 * HTB, NXCD = 8, WGM = 8;

__host__ __device__ __forceinline__ int lds_byte(int r, int c) { const int st = (r >> 4) * 2 + (c >> 5), rr = r & 15, cc = c & 31, ob = rr * 64 + cc * 2; return st * 1024 + (ob ^ (((ob >> 9) & 1) << 5)); }
__host__ __device__ __forceinline__ void stage_rc(int b, int& R, int& C) { const int st = b / 1024, sb = b % 1024, swz = sb ^ (((sb >> 9) & 1) << 5); R = (st >> 1) * 16 + swz / 64; C = (st & 1) * 32 + (swz % 64) / 2; }
__host__ __device__ __forceinline__ int perm32(int rho) { const int n = rho >> 4, i = rho & 15; return 8 * (i >> 2) + 4 * n + (i & 3); }

struct Unit { int pm, pn; };
struct Gemm { const bf16_t* A; const bf16_t* Bt; int M, N, K; int a_rows; };

struct StaticOrder {
    int nM, nN, nwg, G, c;
    __host__ __device__ void init(int M, int N, int G_, int c_) { nM = M / BM; nN = N / BM; nwg = nM * nN; G = G_; c = c_; }
    __host__ __device__ void init_tiles(int nM_, int nN_, int G_, int c_) { nM = nM_; nN = nN_; nwg = nM * nN; G = G_; c = c_; }
    __host__ __device__ bool next(int i, Unit& u) const {
        const long L = (long)i * G + c; if (L >= nwg) return false;
        int wgid = (int)L; { const int q = nwg / NXCD, r = nwg % NXCD, xcd = wgid % NXCD, off = wgid / NXCD; wgid = (xcd < r ? xcd * (q + 1) : r * (q + 1) + (xcd - r) * q) + off; }
        const int nig = WGM * nN, gid = wgid / nig, fm = gid * WGM, gsz = (nM - fm) < WGM ? (nM - fm) : WGM;
        u.pm = fm + ((wgid % nig) % gsz); u.pn = (wgid % nig) / gsz; return true;
    }
    __device__ __forceinline__ void a_ready(const Unit&) const {}
    __device__ __forceinline__ void done(const Unit&) const {}
};

template <class Epi, class Sched, bool ALIGN_EPI = false, bool SP2 = false>
__device__ __forceinline__ void gemm_phase(PG8_LAS unsigned char* lds, const Gemm g, const Sched& S, const Epi& E) {
    int tid_o = threadIdx.x; asm volatile("" : "+v"(tid_o));
    const int tid = tid_o, wid = __builtin_amdgcn_readfirstlane(tid >> 6), lane = tid & 63, wr = wid >> 2, wc = wid & 3, fr = lane & 15, fq = lane >> 4;
    const int K = g.K, nt = K / BK;
    unsigned voffA[2], voffB[2];
#pragma unroll
    for (int i = 0; i < 2; ++i) { int R, C; stage_rc(tid * 16 + i * 8192, R, C); const int Rb = Epi::PERM ? ((R & ~31) + perm32(R & 31)) : R;
        voffA[i] = (unsigned)(R * K + C) * 2u; voffB[i] = (unsigned)(Rb * K + C) * 2u; }
    const size_t kstep = (size_t)(BK * 2);
    const size_t hstep = (size_t)HALF * K * 2;
    const size_t tstep = 2 * hstep;
    const unsigned ldsw = (unsigned)wid * 1024u;
    const int aoff = lds_byte(wr * 64 + fr, fq * 8), boff = lds_byte(wc * 32 + fr, fq * 8);
#define PG8_SA(b, h) (((b) * 2 + (h)) * HTB)
#define PG8_SB(b, h) ((4 + (b) * 2 + (h)) * HTB)
#define PG8_STAGE(bufoff, gbase, voff) do { _Pragma("unroll") for (int _i = 0; _i < 2; ++_i) \
        __builtin_amdgcn_global_load_lds((const unsigned*)((const char*)(gbase) + (voff)[_i]), (PG8_LAS unsigned*)(lds + (bufoff) + ldsw + _i * 8192), 16, 0, 0); } while (0)
#define PG8_LDA(dst, b, h) do { _Pragma("unroll") for (int m = 0; m < 4; ++m) _Pragma("unroll") for (int k = 0; k < 2; ++k) dst[m][k] = *(const PG8_LAS bf16x8*)(lds + PG8_SA(b, h) + aoff + m * 2048 + k * 1024); } while (0)
#define PG8_LDB(dst, b, h) do { _Pragma("unroll") for (int n = 0; n < 2; ++n) _Pragma("unroll") for (int k = 0; k < 2; ++k) dst[n][k] = *(const PG8_LAS bf16x8*)(lds + PG8_SB(b, h) + boff + n * 2048 + k * 1024); } while (0)
#define PG8_MMA(ai, bj, At, Bt) do { __builtin_amdgcn_s_setprio(1); _Pragma("unroll") for (int m = 0; m < 4; ++m) _Pragma("unroll") for (int n = 0; n < 2; ++n) _Pragma("unroll") for (int k = 0; k < 2; ++k) \
        acc[ai][bj][m][n] = __builtin_amdgcn_mfma_f32_16x16x32_bf16(Bt[n][k], At[m][k], acc[ai][bj][m][n], 0, 0, 0); __builtin_amdgcn_s_setprio(0); } while (0)
#define PG8_WAIT_V(n) asm volatile("s_waitcnt vmcnt(" #n ")" ::: "memory")
#define PG8_WAIT_L(n) asm volatile("s_waitcnt lgkmcnt(" #n ")" ::: "memory")
#define PG8_BAR __builtin_amdgcn_s_barrier()
#define PG8_SCHED __builtin_amdgcn_sched_barrier(0)
    Unit cur, nxt; int ui = 0;
    if (!S.next(0, cur)) return;
    f32x4 acc[2][2][4][2];
#pragma unroll
    for (int a = 0; a < 2; ++a)
#pragma unroll
        for (int b = 0; b < 2; ++b)
#pragma unroll
            for (int m = 0; m < 4; ++m)
#pragma unroll
                for (int n = 0; n < 2; ++n) acc[a][b][m][n] = (f32x4){0.f, 0.f, 0.f, 0.f};
    bf16x8 At[4][2], B0[2][2], B1[2][2];
    const size_t tstepA = (size_t)g.a_rows * K * 2; const char* cA = (const char*)g.A + (size_t)cur.pm * tstepA; const char* cB = (const char*)g.Bt + (size_t)cur.pn * tstep;
    S.a_ready(cur);
    if constexpr (SP2) {
        PG8_STAGE(PG8_SB(0, 0), cB, voffB); PG8_STAGE(PG8_SB(0, 1), cB + hstep, voffB); PG8_STAGE(PG8_SA(0, 0), cA, voffA); PG8_STAGE(PG8_SA(0, 1), cA + hstep, voffA);
        if (wr == 1) PG8_BAR;
        PG8_WAIT_V(2); PG8_BAR;
        PG8_STAGE(PG8_SB(1, 0), cB + kstep, voffB); PG8_STAGE(PG8_SA(1, 0), cA + kstep, voffA); PG8_STAGE(PG8_SB(1, 1), cB + hstep + kstep, voffB);
        PG8_WAIT_V(6); PG8_BAR;
    } else {
        PG8_STAGE(PG8_SB(0, 0), cB, voffB); PG8_STAGE(PG8_SA(0, 0), cA, voffA); PG8_STAGE(PG8_SB(0, 1), cB + hstep, voffB); PG8_STAGE(PG8_SA(0, 1), cA + hstep, voffA);
        if (wr == 1) PG8_BAR;
        PG8_WAIT_V(4); PG8_BAR;
        PG8_STAGE(PG8_SB(1, 0), cB + kstep, voffB); PG8_STAGE(PG8_SA(1, 0), cA + kstep, voffA); PG8_STAGE(PG8_SB(1, 1), cB + hstep + kstep, voffB);
        PG8_WAIT_V(6); PG8_BAR;
    }
    for (;;) {
        const bool has_next = S.next(ui + 1, nxt);
        const char* nA = has_next ? (const char*)g.A + (size_t)nxt.pm * tstepA : cA; const char* nB = has_next ? (const char*)g.Bt + (size_t)nxt.pn * tstep : cB;
#pragma unroll 1
        for (int t = 0; t < nt; t += 2) {
            const bool last = (t == nt - 2);
            const char* a1 = cA + (size_t)(t + 1) * kstep;
            const char* a2 = last ? nA : cA + (size_t)(t + 2) * kstep; const char* b2 = last ? nB : cB + (size_t)(t + 2) * kstep;
            const char* a3 = a2 + kstep; const char* b3 = b2 + kstep;
            if (last && has_next) S.a_ready(nxt);
            if constexpr (SP2) {
            PG8_LDB(B0, 0, 0); PG8_LDB(B1, 0, 1); PG8_SCHED; PG8_LDA(At, 0, 0); PG8_STAGE(PG8_SA(1, 1), a1 + hstep, voffA);
            PG8_WAIT_V(8); PG8_WAIT_L(0); PG8_BAR; PG8_MMA(0, 0, At, B0); PG8_MMA(0, 1, At, B1); PG8_BAR; PG8_SCHED;
            PG8_LDA(At, 0, 1); PG8_STAGE(PG8_SB(0, 0), b2, voffB); PG8_STAGE(PG8_SB(0, 1), b2 + hstep, voffB); PG8_STAGE(PG8_SA(0, 0), a2, voffA);
            PG8_WAIT_V(8); PG8_WAIT_L(0); PG8_BAR; PG8_MMA(1, 0, At, B0); PG8_MMA(1, 1, At, B1); PG8_BAR; PG8_SCHED;
            PG8_LDB(B0, 1, 0); PG8_LDB(B1, 1, 1); PG8_SCHED; PG8_LDA(At, 1, 0); PG8_STAGE(PG8_SA(0, 1), a2 + hstep, voffA);
            PG8_WAIT_V(8); PG8_WAIT_L(0); PG8_BAR; PG8_MMA(0, 0, At, B0); PG8_MMA(0, 1, At, B1); PG8_BAR; PG8_SCHED;
            PG8_LDA(At, 1, 1); PG8_STAGE(PG8_SB(1, 0), b3, voffB); PG8_STAGE(PG8_SB(1, 1), b3 + hstep, voffB); PG8_STAGE(PG8_SA(1, 0), a3, voffA);
            PG8_WAIT_V(8); PG8_WAIT_L(0); PG8_BAR; PG8_MMA(1, 0, At, B0); PG8_MMA(1, 1, At, B1); PG8_BAR; PG8_SCHED;
            } else {
            PG8_LDB(B0, 0, 0); PG8_SCHED; PG8_LDA(At, 0, 0); PG8_STAGE(PG8_SA(1, 1), a1 + hstep, voffA);
            PG8_WAIT_L(8); PG8_BAR; PG8_WAIT_L(0); PG8_MMA(0, 0, At, B0); PG8_BAR; PG8_SCHED;
            PG8_LDB(B1, 0, 1); PG8_STAGE(PG8_SB(0, 0), b2, voffB);
            PG8_BAR; PG8_WAIT_L(0); PG8_MMA(0, 1, At, B1); PG8_BAR;
            PG8_LDA(At, 0, 1); PG8_STAGE(PG8_SA(0, 0), a2, voffA);
            PG8_BAR; PG8_WAIT_L(0); PG8_MMA(1, 0, At, B0); PG8_BAR; PG8_SCHED;
            PG8_STAGE(PG8_SB(0, 1), b2 + hstep, voffB);
            PG8_WAIT_V(6); PG8_BAR; PG8_MMA(1, 1, At, B1); PG8_BAR;
            PG8_LDB(B0, 1, 0); PG8_SCHED; PG8_LDA(At, 1, 0); PG8_STAGE(PG8_SA(0, 1), a2 + hstep, voffA);
            PG8_WAIT_L(8); PG8_BAR; PG8_WAIT_L(0); PG8_MMA(0, 0, At, B0); PG8_BAR; PG8_SCHED;
            PG8_LDB(B1, 1, 1); PG8_STAGE(PG8_SB(1, 0), b3, voffB);
            PG8_BAR; PG8_WAIT_L(0); PG8_MMA(0, 1, At, B1); PG8_BAR;
            PG8_LDA(At, 1, 1); PG8_STAGE(PG8_SA(1, 0), a3, voffA);
            PG8_BAR; PG8_WAIT_L(0); PG8_MMA(1, 0, At, B0); PG8_BAR; PG8_SCHED;
            PG8_STAGE(PG8_SB(1, 1), b3 + hstep, voffB);
            PG8_WAIT_V(6); PG8_BAR; PG8_MMA(1, 1, At, B1); PG8_BAR;
            }
        }
        if constexpr (ALIGN_EPI) { if (wr == 0) PG8_BAR; }
        if constexpr (!Epi::AFTER_DRAIN) { E(acc, cur, wr, wc, fr, fq); S.done(cur); }
        if (!has_next) break;
#pragma unroll
        for (int a = 0; a < 2; ++a)
#pragma unroll
            for (int b = 0; b < 2; ++b)
#pragma unroll
                for (int m = 0; m < 4; ++m)
#pragma unroll
                    for (int n = 0; n < 2; ++n) acc[a][b][m][n] = (f32x4){0.f, 0.f, 0.f, 0.f};
        cur = nxt; cA = nA; cB = nB; ++ui;
        if constexpr (ALIGN_EPI) { if (wr == 1) PG8_BAR; }
    }
    PG8_WAIT_V(0);
    if constexpr (!ALIGN_EPI) { if (wr == 0) PG8_BAR; }
    PG8_BAR;
    if constexpr (Epi::AFTER_DRAIN) { E.fused(acc, cur, wr, wc, fr, fq, lds, wid, lane); S.done(cur); }
#undef PG8_SA
#undef PG8_SB
#undef PG8_STAGE
#undef PG8_LDA
#undef PG8_LDB
#undef PG8_MMA
#undef PG8_WAIT_V
#undef PG8_WAIT_L
#undef PG8_BAR
#undef PG8_SCHED
}
}

#ifndef PG8_SP2
#define PG8_SP2 true
#endif
#ifndef PG8_ALIGN
#define PG8_ALIGN true
#endif

namespace mk {
using pg8::bf16_t; using pg8::bf16x8; using pg8::f32x4; using pg8::u32x4; using pg8::Unit;
typedef float f32x16 __attribute__((ext_vector_type(16)));
typedef short bf16x4 __attribute__((ext_vector_type(4)));
typedef unsigned u32x2 __attribute__((ext_vector_type(2)));
#define LAS __attribute__((address_space(3)))

constexpr int D = 1024, NB = 4, T = 4096, M = NB * T, F = 2816;
constexpr int P0W = 3584, P1W = 2816, LIW = 384, LOW = 1792;
constexpr float EPS = 1e-6f, LOG2E = 1.4426950408889634f;
constexpr int NWAVES = 8, NTHREADS = 512;

constexpr size_t MiB = 1u << 20;
constexpr size_t WS_CTL = 0;
constexpr size_t WS_MOD = 1 * MiB;
constexpr size_t WS_CBIAS = WS_MOD + 256 * 1024;
constexpr size_t WS_WEVIN = 2 * MiB;
constexpr size_t WS_WLORA = 9 * MiB;
constexpr size_t WS_WEVOUT = 11 * MiB;
constexpr size_t WS_WUP = 13 * MiB;
constexpr size_t WS_WDN = 35 * MiB;
constexpr size_t WS_WODIN = 46 * MiB;
constexpr size_t WS_WODOUT = 52 * MiB;
constexpr size_t WS_W1T = 54 * MiB;
constexpr size_t WS_HNA = 55 * MiB;
constexpr size_t WS_HN = WS_HNA + 2 * D * 2;
constexpr size_t WS_BIG = 88 * MiB;
constexpr size_t WS_P0 = WS_BIG;
constexpr size_t WS_LI = WS_BIG + 112 * MiB;
constexpr size_t WS_GU = WS_BIG + 112 * MiB;
constexpr size_t WS_GS = WS_BIG + 128 * MiB;
constexpr size_t WS_GD = WS_BIG + 144 * MiB;
constexpr size_t WS_TG = WS_BIG + 145 * MiB;
constexpr size_t WS_RNX = 13 * MiB;
constexpr size_t WS_RGAM = 29 * MiB;
constexpr size_t WS_RCORR = 30 * MiB;
constexpr size_t WS_H = WS_BIG;
constexpr size_t WS_P1 = WS_BIG;
constexpr size_t WS_VTS = WS_BIG + 88 * MiB;
constexpr size_t WS_VTW = WS_BIG + 96 * MiB;
constexpr size_t WS_CMPK = WS_BIG + 104 * MiB;
constexpr size_t WS_CMPVT = WS_CMPK + 512 * 1024;
constexpr size_t WS_END = WS_BIG + 162 * MiB;
constexpr int LDS_BYTES = 147456;
constexpr int LDS_HALO = 131072;
constexpr int LDS_MISC = 131072 + 4096;

__device__ __forceinline__ float bf2f(bf16_t b) { return __uint_as_float((unsigned)b << 16); }
__device__ __forceinline__ float lo_bf(unsigned w) { return __uint_as_float(w << 16); }
__device__ __forceinline__ float hi_bf(unsigned w) { return __uint_as_float(w & 0xffff0000u); }
typedef float f32x2_t __attribute__((ext_vector_type(2))); typedef __bf16 bf16x2_t __attribute__((ext_vector_type(2)));
__device__ __forceinline__ unsigned pk_bf16(float lo, float hi) { f32x2_t v = {lo, hi}; bf16x2_t b = __builtin_convertvector(v, bf16x2_t); return __builtin_bit_cast(unsigned, b); }
__device__ __forceinline__ bf16_t f2bf(float f) { return (bf16_t)(pk_bf16(f, 0.f) & 0xffffu); }
__device__ __forceinline__ float frcp(float x) { return __builtin_amdgcn_rcpf(x); }
__device__ __forceinline__ float fsigmoid(float x) { return frcp(1.f + __expf(-x)); }
__device__ __forceinline__ float fsilu(float x) { return x * frcp(1.f + __expf(-x)); }
__device__ __forceinline__ float ftanh(float x) { return 2.f * frcp(1.f + __expf(-2.f * x)) - 1.f; }
__device__ __forceinline__ float fsoftplus(float x) { return fmaxf(x, 0.f) + __logf(1.f + __expf(-fabsf(x))); }
__device__ __forceinline__ float fgelu(float x) { const float y = 0.7978845608028654f * (x + 0.044715f * x * x * x); return x * frcp(1.f + __expf(-2.f * y)); }
__device__ __forceinline__ float wave_sum(float v) {
#pragma unroll
    for (int o = 32; o > 0; o >>= 1) v += __shfl_xor(v, o);
    return v;
}
template <int CTRL> __device__ __forceinline__ float dppf(float x) { return __builtin_bit_cast(float, __builtin_amdgcn_update_dpp(0, __builtin_bit_cast(int, x), CTRL, 0xf, 0xf, true)); }
__device__ __forceinline__ float red16(float x) { x += dppf<0xB1>(x); x += dppf<0x4E>(x); x += dppf<0x124>(x); x += dppf<0x128>(x); return x; }
#define LDS_WAIT() asm volatile("s_waitcnt lgkmcnt(0)" ::: "memory")
#define BLOCK_SYNC() __syncthreads()
#define LBAR() do { asm volatile("s_waitcnt lgkmcnt(0)" ::: "memory"); __builtin_amdgcn_s_barrier(); asm volatile("" ::: "memory"); } while (0)

struct Ptrs {
    const float* in[35];
    float* out;
    unsigned char* ws;
};

__device__ __forceinline__ void conv_item(const float* W, int ldw, int k0, int n0, int kvalid, int nvalid, bf16_t* WT, int ldt, int drow0, int dk0, LAS float* scr, int lane) {
    const int nn = lane & 31;
#pragma unroll 8
    for (int i = 0; i < 32; ++i) { const int kk = 2 * i + (lane >> 5); float v = 0.f; if (W != nullptr && kk < kvalid && nn < nvalid) v = W[(size_t)(k0 + kk) * ldw + n0 + nn]; scr[kk * 33 + nn] = v; }
    LDS_WAIT(); asm volatile("" ::: "memory");
    const int c = lane & 7;
#pragma unroll
    for (int j = 0; j < 4; ++j) { const int n = (lane >> 3) + 8 * j; const LAS float* s = scr + (8 * c) * 33 + n;
        u32x4 o; o.x = pk_bf16(s[0 * 33], s[1 * 33]); o.y = pk_bf16(s[2 * 33], s[3 * 33]); o.z = pk_bf16(s[4 * 33], s[5 * 33]); o.w = pk_bf16(s[6 * 33], s[7 * 33]);
        *(u32x4*)(WT + (size_t)(drow0 + n) * ldt + dk0 + 8 * c) = o; }
    LDS_WAIT(); asm volatile("" ::: "memory");
}

__device__ __forceinline__ void prologue(const Ptrs& P, LAS unsigned char* lds, int tid, int lane, int wave, int bid, int G, const bool late) {
    unsigned char* ws = P.ws;
    if (!late)
    {
        LAS float* sc = (LAS float*)(lds + 72 * 1024);
        LAS float* part = sc + 4096;
        const float* c = P.in[1];
        for (int i = tid; i < 4096; i += NTHREADS) sc[i] = fsilu(c[i]);
        BLOCK_SYNC();
        for (int cb = bid; cb < 256; cb += G) {
            const int l = cb >> 7, j0 = (cb & 127) * 48;
            if (tid < 480) {
                const int kg = tid / 48, cj = tid % 48;
                const float* w = P.in[2] + (size_t)l * D * 6144 + j0 + cj;
                float a0 = 0.f, a1 = 0.f, a2 = 0.f, a3 = 0.f;
                for (int k = kg; k < D; k += 10) { const float wv = w[(size_t)k * 6144]; a0 += sc[k] * wv; a1 += sc[1024 + k] * wv; a2 += sc[2048 + k] * wv; a3 += sc[3072 + k] * wv; }
                part[(kg * 4 + 0) * 48 + cj] = a0; part[(kg * 4 + 1) * 48 + cj] = a1; part[(kg * 4 + 2) * 48 + cj] = a2; part[(kg * 4 + 3) * 48 + cj] = a3;
            }
            BLOCK_SYNC();
            if (tid < 192) {
                const int b = tid / 48, cj = tid % 48;
                float s = P.in[3][l * 6144 + j0 + cj];
                for (int kg = 0; kg < 10; ++kg) s += part[(kg * 4 + b) * 48 + cj];
                ((float*)(ws + WS_MOD))[((size_t)l * NB + b) * 6144 + j0 + cj] = s;
            }
            BLOCK_SYNC();
        }
        if (bid >= G - 2) {
            const int which = bid - (G - 2);
            const float* pe = P.in[which ? 30 : 27]; const float* w1 = P.in[which ? 31 : 28];
            const int j = tid & 63, pt = tid >> 6;
            float a = 0.f;
            for (int k = pt * 256; k < pt * 256 + 256; ++k) a += pe[k] * w1[(size_t)k * 64 + j];
            part[pt * 64 + j] = a;
            BLOCK_SYNC();
            if (tid < 64) { float s = 0.f; for (int p = 0; p < 8; ++p) s += part[p * 64 + tid]; ((float*)(ws + WS_CBIAS))[which * 64 + tid] = s; }
            BLOCK_SYNC();
        }
    }
    LAS float* scr = (LAS float*)(lds + wave * 8448);
    const int gw = bid * NWAVES + wave, NGW = G * NWAVES;
    constexpr int I_EVIN = 16 * 112, I_LORA = 6 * 56, I_EVOUT = 16 * 32, I_UP = 16 * 176, I_DN = 44 * 32, I_ODIN = 16 * 88, I_ODOUT = 16 * 32, I_W1 = 32 * 2;
    constexpr int NITEMS = I_EVIN + I_LORA + I_EVOUT + 2 * I_UP + 2 * I_DN + I_ODIN + I_ODOUT + 2 * I_W1, NEARLY = I_EVIN + I_LORA + I_EVOUT;
    const int it_lo = late ? NEARLY : 0, it_hi = late ? NITEMS : NEARLY;
    for (int it = it_lo + gw; it < it_hi; it += NGW) {
        int r = it;
        if (r < I_EVIN) { const int kb = r / 112, nb = r % 112, n0 = nb * 32; const int nv = 3344 - n0;
            conv_item(nv > 0 ? P.in[10] : nullptr, 3344, kb * 64, n0, 64, nv, (bf16_t*)(ws + WS_WEVIN), D, n0, kb * 64, scr, lane); continue; } r -= I_EVIN;
        if (r < I_LORA) { const int kb = r / 56, nb = r % 56, n0 = nb * 32; const float* W = nullptr; int ldw = 512, sk0 = 0, sn0 = 0, kv = 64;
            if (n0 < 512) { if (kb == 0) { W = P.in[16]; sn0 = n0; } }
            else if (n0 < 1024) { if (kb == 1) { W = P.in[18]; sn0 = n0 - 512; } }
            else if (n0 < 1536) { if (kb == 2 || kb == 3) { W = P.in[19]; sn0 = n0 - 1024; sk0 = (kb - 2) * 64; } }
            else { if (kb == 4) { W = P.in[12]; ldw = 256; sn0 = n0 - 1536; kv = 16; } }
            conv_item(W, ldw, sk0, sn0, kv, 32, (bf16_t*)(ws + WS_WLORA), LIW, n0, kb * 64, scr, lane); continue; } r -= I_LORA;
        if (r < I_EVOUT) { const int kb = r / 32, nb = r % 32; conv_item(P.in[25], D, kb * 64, nb * 32, 64, 32, (bf16_t*)(ws + WS_WEVOUT), D, nb * 32, kb * 64, scr, lane); continue; } r -= I_EVOUT;
        if (r < 2 * I_UP) { const int l = r / I_UP; r %= I_UP; const int kb = r / 176, nb = r % 176, n0 = nb * 32;
            const int f0 = n0 < F ? n0 : n0 - F; const int drow = (f0 >> 7) * 256 + (n0 < F ? 0 : 128) + (f0 & 127);
            conv_item(P.in[6] + (size_t)l * D * 2 * F, 2 * F, kb * 64, n0, 64, 32, (bf16_t*)(ws + WS_WUP) + (size_t)l * 2 * F * D, D, drow, kb * 64, scr, lane); continue; } r -= 2 * I_UP;
        if (r < 2 * I_DN) { const int l = r / I_DN; r %= I_DN; const int kb = r / 32, nb = r % 32;
            conv_item(P.in[9] + (size_t)l * F * D, D, kb * 64, nb * 32, 64, 32, (bf16_t*)(ws + WS_WDN) + (size_t)l * D * F, F, nb * 32, kb * 64, scr, lane); continue; } r -= 2 * I_DN;
        if (r < I_ODIN) { const int kb = r / 88, nb = r % 88, n0 = nb * 32; const int nv = 2608 - n0;
            conv_item(nv > 0 ? P.in[26] : nullptr, 2608, kb * 64, n0, 64, nv, (bf16_t*)(ws + WS_WODIN), D, n0, kb * 64, scr, lane); continue; } r -= I_ODIN;
        if (r < I_ODOUT) { const int kb = r / 32, nb = r % 32; conv_item(P.in[33], D, kb * 64, nb * 32, 64, 32, (bf16_t*)(ws + WS_WODOUT), D, nb * 32, kb * 64, scr, lane); continue; } r -= I_ODOUT;
        { const int which = r / I_W1; r %= I_W1; const int kb = r / 2, nb = r % 2;
            conv_item(P.in[which ? 31 : 28], 64, kb * 64, nb * 32, 64, 32, (bf16_t*)(ws + WS_W1T) + (size_t)which * 64 * 2048, 2048, nb * 32, kb * 64, scr, lane); }
    }
}

__device__ __forceinline__ void norm_phase(const float* X, const float* g, const float* mod  , int sh_off, int sc_off, bf16_t* HN, float* OUTF, int gw, int NGW, int lane) {
    f32x4 gg[4];
#pragma unroll
    for (int j = 0; j < 4; ++j) gg[j] = *(const f32x4*)(g + 4 * lane + 256 * j);
    for (int m = gw; m < M; m += NGW) {
        const f32x4* xr = (const f32x4*)(X + (size_t)m * D) + lane;
        f32x4 v[4]; float s = 0.f;
#pragma unroll
        for (int j = 0; j < 4; ++j) { v[j] = xr[64 * j]; s += (v[j].x * v[j].x + v[j].y * v[j].y) + (v[j].z * v[j].z + v[j].w * v[j].w); }
        const float rstd = rsqrtf(wave_sum(s) * (1.f / D) + EPS);
        if (OUTF) {
            f32x4* o = (f32x4*)(OUTF + (size_t)m * D) + lane;
#pragma unroll
            for (int j = 0; j < 4; ++j) o[64 * j] = v[j] * rstd * gg[j];
        } else {
            const float* mb = mod + (size_t)(m >> 12) * 6144;
            u32x2* o = (u32x2*)(HN + (size_t)m * D) + lane;
#pragma unroll
            for (int j = 0; j < 4; ++j) {
                const f32x4 sc = *(const f32x4*)(mb + sc_off + 4 * lane + 256 * j), sh = *(const f32x4*)(mb + sh_off + 4 * lane + 256 * j);
                const f32x4 y = v[j] * rstd * gg[j] * (sc + 1.f) + sh;
                u32x2 w; w.x = pk_bf16(y.x, y.y); w.y = pk_bf16(y.z, y.w); o[64 * j] = w;
            }
        }
    }
}

struct EpiStore {
    static constexpr bool PERM = true, AFTER_DRAIN = false;
    bf16_t* O; int ldc; int nvalid;
    __device__ __forceinline__ void operator()(const f32x4 (&acc)[2][2][4][2], const Unit& u, int wr, int wc, int fr, int fq) const {
        const int row0 = u.pm * 256 + wr * 64 + fr, col0 = u.pn * 256 + wc * 32 + 8 * fq;
#pragma unroll
        for (int ai = 0; ai < 2; ++ai)
#pragma unroll
            for (int m = 0; m < 4; ++m) { bf16_t* rowp = O + (size_t)(row0 + ai * 128 + m * 16) * ldc + col0;
#pragma unroll
                for (int bj = 0; bj < 2; ++bj) { if (col0 + bj * 128 < nvalid) { const f32x4 v0 = acc[ai][bj][m][0], v1 = acc[ai][bj][m][1];
                    u32x4 w; w.x = pk_bf16(v0[0], v0[1]); w.y = pk_bf16(v0[2], v0[3]); w.z = pk_bf16(v1[0], v1[1]); w.w = pk_bf16(v1[2], v1[3]); *(u32x4*)(rowp + bj * 128) = w; } } }
    }
};
struct EpiLora {
    static constexpr bool PERM = true, AFTER_DRAIN = false;
    bf16_t* O; const float* w0; const float* a0; const float* a_b;
    __device__ __forceinline__ void operator()(const f32x4 (&acc)[2][2][4][2], const Unit& u, int wr, int wc, int fr, int fq) const {
        const int row0 = u.pm * 256 + wr * 64 + fr, col0 = u.pn * 256 + wc * 32 + 8 * fq;
        const int kind = u.pn >> 1;
        const float* bias = kind == 0 ? w0 + col0 : kind == 1 ? a0 + (col0 - 512) : kind == 3 ? a_b + (col0 - 1536) : nullptr;
#pragma unroll
        for (int bj = 0; bj < 2; ++bj)
#pragma unroll
            for (int n = 0; n < 2; ++n) {
                const f32x4 bv = bias ? *(const f32x4*)(bias + bj * 128 + 4 * n) : (f32x4){0.f, 0.f, 0.f, 0.f};
#pragma unroll
                for (int ai = 0; ai < 2; ++ai)
#pragma unroll
                    for (int m = 0; m < 4; ++m) {
                        float v[4];
#pragma unroll
                        for (int e = 0; e < 4; ++e) { const float z = acc[ai][bj][m][n][e] + bv[e]; float o;
                            if (kind == 0) o = -0.6065306597126334f * fsigmoid(z); else if (kind == 1) o = fsigmoid(z); else if (kind == 2) o = z; else o = -fsoftplus(-z) * (1.f / 16.f);
                            v[e] = o; }
                        u32x2 w; w.x = pk_bf16(v[0], v[1]); w.y = pk_bf16(v[2], v[3]);
                        *(u32x2*)(O + (size_t)(row0 + ai * 128 + m * 16) * LOW + col0 + bj * 128 + 4 * n) = w;
                    }
            }
    }
};
struct EpiRes {
    static constexpr bool PERM = true, AFTER_DRAIN = false;
    const float* base; float* out; const float* gate  ;
    __device__ __forceinline__ void operator()(const f32x4 (&acc)[2][2][4][2], const Unit& u, int wr, int wc, int fr, int fq) const {
        const int row0 = u.pm * 256 + wr * 64 + fr, col0 = u.pn * 256 + wc * 32 + 8 * fq;
        const float* gp = gate + (size_t)(u.pm >> 4) * 6144 + col0;
        f32x4 gv[2][2];
#pragma unroll
        for (int bj = 0; bj < 2; ++bj)
#pragma unroll
            for (int n = 0; n < 2; ++n) gv[bj][n] = *(const f32x4*)(gp + bj * 128 + 4 * n);
#pragma unroll
        for (int ai = 0; ai < 2; ++ai)
#pragma unroll
            for (int m = 0; m < 4; ++m) { const size_t off = (size_t)(row0 + ai * 128 + m * 16) * D + col0;
#pragma unroll
                for (int bj = 0; bj < 2; ++bj)
#pragma unroll
                    for (int n = 0; n < 2; ++n) { const f32x4 b = *(const f32x4*)(base + off + bj * 128 + 4 * n); *(f32x4*)(out + off + bj * 128 + 4 * n) = b + gv[bj][n] * acc[ai][bj][m][n]; } }
    }
};
struct EpiConv {
    static constexpr bool PERM = true, AFTER_DRAIN = false;
    bf16_t* H; const float* cw; const float* cb; LAS float* halo;
    __device__ __forceinline__ void operator()(const f32x4 (&acc)[2][2][4][2], const Unit& u, int wr, int wc, int fr, int fq) const {
        const int f0 = u.pn * 128 + wc * 32 + 8 * fq, lcol = wc * 32 + 8 * fq;
        float c0[8], c1[8], c2[8], cbv[8];
#pragma unroll
        for (int e = 0; e < 8; ++e) { c0[e] = cw[f0 + e]; c1[e] = cw[F + f0 + e]; c2[e] = cw[2 * F + f0 + e]; cbv[e] = cb[f0 + e]; }
        if (fr >= 14) {
#pragma unroll
            for (int ai = 0; ai < 2; ++ai)
#pragma unroll
                for (int n = 0; n < 2; ++n) *(LAS f32x4*)(halo + ((ai * 2 + wr) * 2 + (fr - 14)) * 128 + lcol + 4 * n) = acc[ai][0][3][n];
        }
        asm volatile("s_waitcnt lgkmcnt(0)" ::: "memory"); __builtin_amdgcn_s_barrier(); asm volatile("" ::: "memory");
#pragma unroll
        for (int ai = 0; ai < 2; ++ai)
#pragma unroll
            for (int m = 0; m < 4; ++m) {
                const int lrow = ai * 128 + wr * 64 + m * 16 + fr;
                const int grow = u.pm * 254 - 2 + lrow;
                const int t = grow & (T - 1);
                float hA[8], hB[8];
                if (m == 0) {
                    const int idx = ai * 2 + wr - 1;
#pragma unroll
                    for (int e = 0; e < 8; ++e) { hA[e] = 0.f; hB[e] = 0.f; }
                    if (idx >= 0 && fr < 2) {
#pragma unroll
                        for (int n = 0; n < 2; ++n) { const f32x4 a = *(LAS f32x4*)(halo + (idx * 2 + 1) * 128 + lcol + 4 * n), b = *(LAS f32x4*)(halo + (idx * 2 + 0) * 128 + lcol + 4 * n);
#pragma unroll
                            for (int e = 0; e < 4; ++e) { hA[n * 4 + e] = a[e]; hB[n * 4 + e] = b[e]; } }
                    }
                }
                float o[8];
#pragma unroll
                for (int n = 0; n < 2; ++n)
#pragma unroll
                    for (int e = 0; e < 4; ++e) {
                        const float cur = acc[ai][0][m][n][e];
                        float p1 = dppf<0x121>(cur), p2 = dppf<0x122>(cur);
                        if (m > 0) { const float pv = acc[ai][0][m - 1][n][e]; const float q1 = dppf<0x121>(pv), q2 = dppf<0x122>(pv); if (fr < 1) p1 = q1; if (fr < 2) p2 = q2; }
                        else { if (fr < 1) p1 = hA[n * 4 + e]; if (fr < 2) p2 = (fr == 1) ? hA[n * 4 + e] : hB[n * 4 + e]; }
                        if (t == 0) p1 = 0.f;
                        if (t <= 1) p2 = 0.f;
                        const int ee = n * 4 + e;
                        const float uc = cbv[ee] + c0[ee] * p2 + c1[ee] * p1 + c2[ee] * cur;
                        o[ee] = fgelu(uc) * acc[ai][1][m][n][e];
                    }
                if (lrow >= 2 && grow < M) { u32x4 w; w.x = pk_bf16(o[0], o[1]); w.y = pk_bf16(o[2], o[3]); w.z = pk_bf16(o[4], o[5]); w.w = pk_bf16(o[6], o[7]); *(u32x4*)(H + (size_t)grow * F + f0) = w; }
            }
    }
};

__device__ __forceinline__ void lora_in_phase(const bf16_t* P0, const float* mu, bf16_t* LI, int gw, int NGW, int lane) {
    for (int m = gw; m < M; m += NGW) {
        const bf16_t* row = P0 + (size_t)m * P0W; const bool hasp = (m & (T - 1)) != 0;
#pragma unroll
        for (int i = 0; i < 6; ++i) {
            const int j = lane + 64 * i; float o = 0.f;
            if (j < 256) { const int c = j < 64 ? 512 + j : j < 128 ? 1600 + (j - 64) : 1664 + (j - 128);
                const float p = bf2f(row[1552 + c]); const float pp = hasp ? bf2f(row[1552 + c - P0W]) : 0.f; const float s = p + (pp - p) * mu[c];
                o = j < 64 ? ftanh(s) : j < 128 ? s : fsigmoid(s); }
            else if (j < 272) o = bf2f(row[1536 + j - 256]);
            LI[(size_t)m * LIW + j] = f2bf(o);
        }
    }
}

__device__ __forceinline__ f32x4 mfma16(bf16x8 a, bf16x8 b, f32x4 c) { return __builtin_amdgcn_mfma_f32_16x16x32_bf16(a, b, c, 0, 0, 0); }
__device__ __forceinline__ f32x16 mfma32(bf16x8 a, bf16x8 b, f32x16 c) { return __builtin_amdgcn_mfma_f32_32x32x16_bf16(a, b, c, 0, 0, 0); }


__device__ __forceinline__ void sub_barrier(unsigned* cnt, unsigned target) {
    asm volatile("s_waitcnt vmcnt(0)" ::: "memory");
    __syncthreads();
    if (threadIdx.x == 0) {
        __builtin_amdgcn_fence(__ATOMIC_RELEASE, "agent");
        asm volatile("s_waitcnt vmcnt(0)" ::: "memory");
        __hip_atomic_fetch_add(cnt, 1u, __ATOMIC_RELAXED, __HIP_MEMORY_SCOPE_AGENT);
        unsigned sp = 0;
        while (__hip_atomic_load(cnt, __ATOMIC_RELAXED, __HIP_MEMORY_SCOPE_AGENT) < target) { __builtin_amdgcn_s_sleep(2); if (++sp > (1u << 22)) break; }
        __builtin_amdgcn_fence(__ATOMIC_ACQUIRE, "agent");
        asm volatile("s_waitcnt vmcnt(0)" ::: "memory");
    }
    __syncthreads();
}

struct GlaRegs { unsigned short la[8], q[8], k[8], og[16]; u32x4 v0, v1, s0, s1; };
template <bool ST3>
__device__ __forceinline__ void gla_load(GlaRegs& R, int unit, const bf16_t* P0, const bf16_t* LO, const bf16_t* GS, int tid) {
    const int bh = unit >> 6, ch = unit & 63, b = bh >> 2, h = bh & 3, lane = tid & 63, w = tid >> 6, g4 = lane >> 4, c16 = lane & 15;
    const size_t row0 = (size_t)b * T + ch * 64;
#pragma unroll
    for (int i = 0; i < 8; ++i) { const size_t r = row0 + w * 8 + i; R.la[i] = LO[r * LOW + 1536 + h * 64 + lane]; R.k[i] = P0[r * P0W + 256 + h * 64 + lane]; if (ST3) R.q[i] = P0[r * P0W + h * 64 + lane]; }
    { const int s = tid >> 3, vg = tid & 7; const u32x4* vp = (const u32x4*)(P0 + (row0 + s) * P0W + 512 + h * 128 + vg * 16); R.v0 = vp[0]; R.v1 = vp[1]; }
    if (ST3) {
#pragma unroll
        for (int ti = 0; ti < 4; ++ti)
#pragma unroll
            for (int rg = 0; rg < 4; ++rg) R.og[ti * 4 + rg] = P0[(row0 + 16 * ti + 4 * g4 + rg) * P0W + 1024 + h * 128 + 16 * w + c16];
        const bf16_t* sp = GS + ((size_t)unit * 128 + 16 * w + c16) * 64 + 8 * g4;
        R.s0 = *(const u32x4*)sp; R.s1 = *(const u32x4*)(sp + 32);
    }
}
__device__ __forceinline__ void gla_stage1(const GlaRegs& R, LAS unsigned char* lds, int unit, bf16_t* GU, float* GD, int tid) {
    const int lane = tid & 63, w = tid >> 6, g4 = lane >> 4, c16 = lane & 15;
    LAS bf16_t* KH = (LAS bf16_t*)lds;
    LAS bf16_t* VT = KH + 64 * 72;
    LAS float* CS = (LAS float*)(VT + 128 * 72);
    float cum[8]; float cs = 0.f;
#pragma unroll
    for (int i = 0; i < 8; ++i) { cs += bf2f(R.la[i]); cum[i] = cs; }
    CS[w * 64 + lane] = cs;
    { const int s = tid >> 3, vg = tid & 7; const unsigned vw[8] = {R.v0.x, R.v0.y, R.v0.z, R.v0.w, R.v1.x, R.v1.y, R.v1.z, R.v1.w};
#pragma unroll
      for (int j = 0; j < 8; ++j) { VT[(vg * 16 + 2 * j) * 72 + s] = (bf16_t)(vw[j] & 0xffffu); VT[(vg * 16 + 2 * j + 1) * 72 + s] = (bf16_t)(vw[j] >> 16); } }
    LBAR();
    float pre = 0.f, tot = 0.f;
#pragma unroll
    for (int s2 = 0; s2 < 8; ++s2) { const float v = CS[s2 * 64 + lane]; tot += v; if (s2 < w) pre += v; }
#pragma unroll
    for (int i = 0; i < 8; ++i) { const float bb = pre + cum[i]; KH[lane * 72 + w * 8 + i] = f2bf(bf2f(R.k[i]) * __expf(tot - bb)); }
    if (w == 0) GD[(size_t)unit * 64 + lane] = __expf(tot);
    LBAR();
    bf16x8 vb[2];
#pragma unroll
    for (int st = 0; st < 2; ++st) vb[st] = *(LAS bf16x8*)(VT + (16 * w + c16) * 72 + 32 * st + 8 * g4);
#pragma unroll
    for (int kt = 0; kt < 4; ++kt) {
        f32x4 acc = (f32x4){0.f, 0.f, 0.f, 0.f};
#pragma unroll
        for (int st = 0; st < 2; ++st) { const bf16x8 a = *(LAS bf16x8*)(KH + (16 * kt + c16) * 72 + 32 * st + 8 * g4); acc = mfma16(a, vb[st], acc); }
        u32x2 o; o.x = pk_bf16(acc[0], acc[1]); o.y = pk_bf16(acc[2], acc[3]);
        *(u32x2*)(GU + ((size_t)unit * 128 + 16 * w + c16) * 64 + 16 * kt + 4 * g4) = o;
    }
    LBAR();
}
__device__ __forceinline__ void gla_stage2(const bf16_t* GU, const float* GD, bf16_t* GS, int e2  ) {
    const int bh = e2 >> 12, vk = (e2 & 4095) * 2, k = vk & 63;
    float s0 = 0.f, s1 = 0.f;
    unsigned un = *(const unsigned*)(GU + ((size_t)bh * 64) * 8192 + vk);
    f32x2_t dn = *(const f32x2_t*)(GD + ((size_t)bh * 64) * 64 + k);
    for (int c = 0; c < 64; ++c) {
        const size_t base = ((size_t)bh * 64 + c) * 8192 + vk;
        const unsigned u = un; const f32x2_t d = dn;
        if (c + 1 < 64) { un = *(const unsigned*)(GU + base + 8192); dn = *(const f32x2_t*)(GD + ((size_t)bh * 64 + c + 1) * 64 + k); }
        *(unsigned*)(GS + base) = pk_bf16(s0, s1);
        s0 = d.x * s0 + lo_bf(u); s1 = d.y * s1 + hi_bf(u);
    }
}
__device__ __forceinline__ void gla_stage3(const GlaRegs& R, LAS unsigned char* lds, int unit, const float gg, bf16_t* MIX, int tid) {
    const int bh = unit >> 6, ch = unit & 63, b = bh >> 2, h = bh & 3, lane = tid & 63, w = tid >> 6, g4 = lane >> 4, c16 = lane & 15;
    const size_t row0 = (size_t)b * T + ch * 64;
    LAS bf16_t* QT = (LAS bf16_t*)lds;
    LAS bf16_t* KT = QT + 64 * 72;
    LAS bf16_t* VT = KT + 64 * 72;
    LAS bf16_t* PP = VT + 128 * 72;
    LAS float* CS = (LAS float*)(PP + 64 * 72);
    LAS float* SS = CS + 512;
    LAS float* RS = SS + 512;
    float cum[8]; float cs = 0.f;
#pragma unroll
    for (int i = 0; i < 8; ++i) { cs += bf2f(R.la[i]); cum[i] = cs; }
    CS[w * 64 + lane] = cs;
    { const int s = tid >> 3, vg = tid & 7; const unsigned vw[8] = {R.v0.x, R.v0.y, R.v0.z, R.v0.w, R.v1.x, R.v1.y, R.v1.z, R.v1.w};
#pragma unroll
      for (int j = 0; j < 8; ++j) { VT[(vg * 16 + 2 * j) * 72 + s] = (bf16_t)(vw[j] & 0xffffu); VT[(vg * 16 + 2 * j + 1) * 72 + s] = (bf16_t)(vw[j] >> 16); } }
    LBAR();
    float pre = 0.f;
#pragma unroll
    for (int s2 = 0; s2 < 8; ++s2) { const float v = CS[s2 * 64 + lane]; if (s2 < w) pre += v; }
#pragma unroll
    for (int i = 0; i < 8; ++i) { const float bb = pre + cum[i]; const int t = w * 8 + i;
        QT[t * 72 + lane] = f2bf(bf2f(R.q[i]) * __expf(bb) * 0.125f); KT[t * 72 + lane] = f2bf(bf2f(R.k[i]) * __expf(-bb)); }
    LBAR();
#pragma unroll
    for (int q2 = 0; q2 < 2; ++q2) {
        const int tile = 2 * w + q2, ti = tile >> 2, si = tile & 3;
        f32x4 acc = (f32x4){0.f, 0.f, 0.f, 0.f};
        if (si <= ti) {
#pragma unroll
            for (int st = 0; st < 2; ++st) { const bf16x8 a = *(LAS bf16x8*)(QT + (16 * ti + c16) * 72 + 32 * st + 8 * g4), bb = *(LAS bf16x8*)(KT + (16 * si + c16) * 72 + 32 * st + 8 * g4); acc = mfma16(a, bb, acc); }
        }
#pragma unroll
        for (int rg = 0; rg < 4; ++rg) { const int t = 16 * ti + 4 * g4 + rg, s = 16 * si + c16; PP[t * 72 + s] = f2bf(s <= t ? acc[rg] : 0.f); }
    }
    LBAR();
    f32x4 O[4];
    bf16x8 vb[2];
#pragma unroll
    for (int st = 0; st < 2; ++st) vb[st] = *(LAS bf16x8*)(VT + (16 * w + c16) * 72 + 32 * st + 8 * g4);
    const bf16x8 sf0 = __builtin_bit_cast(bf16x8, R.s0), sf1 = __builtin_bit_cast(bf16x8, R.s1);
#pragma unroll
    for (int ti = 0; ti < 4; ++ti) {
        f32x4 acc = (f32x4){0.f, 0.f, 0.f, 0.f};
#pragma unroll
        for (int st = 0; st < 2; ++st) { const bf16x8 a = *(LAS bf16x8*)(PP + (16 * ti + c16) * 72 + 32 * st + 8 * g4); acc = mfma16(a, vb[st], acc); }
        { const bf16x8 a0 = *(LAS bf16x8*)(QT + (16 * ti + c16) * 72 + 8 * g4), a1 = *(LAS bf16x8*)(QT + (16 * ti + c16) * 72 + 32 + 8 * g4); acc = mfma16(a0, sf0, acc); acc = mfma16(a1, sf1, acc); }
        O[ti] = acc;
    }
#pragma unroll
    for (int ti = 0; ti < 4; ++ti)
#pragma unroll
        for (int rg = 0; rg < 4; ++rg) { const float q = red16(O[ti][rg] * O[ti][rg]); if (c16 == 0) SS[w * 64 + 16 * ti + 4 * g4 + rg] = q; }
    LBAR();
    if (tid < 64) { float s = 0.f;
#pragma unroll
        for (int w2 = 0; w2 < 8; ++w2) s += SS[w2 * 64 + tid]; RS[tid] = rsqrtf(s * (1.f / 128.f) + EPS); }
    LBAR();
#pragma unroll
    for (int ti = 0; ti < 4; ++ti)
#pragma unroll
        for (int rg = 0; rg < 4; ++rg) { const int t = 16 * ti + 4 * g4 + rg; const size_t r = row0 + t; const int v = 16 * w + c16;
            MIX[r * D + h * 128 + v] = f2bf(O[ti][rg] * RS[t] * gg * fsilu(bf2f(R.og[ti * 4 + rg]))); }
    LBAR();
}
__device__ __forceinline__ void gla_part12(LAS unsigned char* lds, int gb, int nblk, const bf16_t* P0, const bf16_t* LO, bf16_t* GU, bf16_t* GS, float* GD, unsigned* subcnt, int tid) {
    {
        GlaRegs Rc, Rn;
        if (gb < 1024) gla_load<false>(Rc, gb, P0, LO, GS, tid);
        for (int u = gb; u < 1024; u += nblk) {
            if (u + nblk < 1024) gla_load<false>(Rn, u + nblk, P0, LO, GS, tid);
            gla_stage1(Rc, lds, u, GU, GD, tid);
            Rc = Rn;
        }
    }
    sub_barrier(subcnt, (unsigned)nblk);
    for (int e2 = gb * NTHREADS + tid; e2 < 65536; e2 += nblk * NTHREADS) gla_stage2(GU, GD, GS, e2);
}
__device__ __forceinline__ void gla_part3(LAS unsigned char* lds, int gb, int nblk, const bf16_t* P0, const bf16_t* LO, const float* gla_g, const bf16_t* GS, bf16_t* MIX, int tid) {
    const float gg = gla_g[16 * (tid >> 6) + (tid & 15)];
    GlaRegs Rc, Rn;
    if (gb < 1024) gla_load<true>(Rc, gb, P0, LO, GS, tid);
    for (int u = gb; u < 1024; u += nblk) {
        if (u + nblk < 1024) gla_load<true>(Rn, u + nblk, P0, LO, GS, tid);
        gla_stage3(Rc, lds, u, gg, MIX, tid);
        Rc = Rn;
    }
}

constexpr int RS = 72;
constexpr int SLOTE = 64 * RS;
struct RwRegs { u32x2 r[2], k[2], v[2], rp[2], kp[2], vp[2], lw[2], a[2]; };
struct RwConst { float mr[4], mkk[4], mv[4], kk_[4], ka_[4], rk_[4]; };
struct RwPrep { float rs[2][4], kk[2][4], bq[2][4], k2[2][4], vs[2][4], lw[2][4]; };
__device__ __forceinline__ void rw_consts(RwConst& C, int h, int sub, const float* mu, const float* k_k, const float* k_a, const float* r_k) {
    const int c0 = h * 64 + 4 * sub;
#pragma unroll
    for (int e = 0; e < 4; ++e) { C.mr[e] = mu[c0 + e]; C.mkk[e] = mu[576 + c0 + e]; C.mv[e] = mu[1088 + c0 + e]; C.kk_[e] = k_k[c0 + e]; C.ka_[e] = k_a[c0 + e]; C.rk_[e] = r_k[c0 + e]; }
}
__device__ __forceinline__ void rw_load(RwRegs& R, int bh, int ch, const bf16_t* P0, const bf16_t* LO, int tid) {
    const int b = bh >> 3, h = bh & 7, sub = tid & 15, c0 = h * 64 + 4 * sub;
#pragma unroll
    for (int i = 0; i < 2; ++i) {
        const int t = ch * 64 + (tid >> 4) + 32 * i; const size_t gr = (size_t)b * T + t;
        const bf16_t* p = P0 + gr * P0W + 1552 + c0;
        R.r[i] = *(const u32x2*)p; R.k[i] = *(const u32x2*)(p + 576); R.v[i] = *(const u32x2*)(p + 1088);
        if (t > 0) { R.rp[i] = *(const u32x2*)(p - P0W); R.kp[i] = *(const u32x2*)(p - P0W + 576); R.vp[i] = *(const u32x2*)(p - P0W + 1088); }
        else { R.rp[i] = (u32x2){0u, 0u}; R.kp[i] = R.rp[i]; R.vp[i] = R.rp[i]; }
        R.lw[i] = *(const u32x2*)(LO + gr * LOW + c0); R.a[i] = *(const u32x2*)(LO + gr * LOW + 512 + c0);
    }
}
__device__ __forceinline__ void unpack4(const u32x2 q, float (&o)[4]) { o[0] = lo_bf(q.x); o[1] = hi_bf(q.x); o[2] = lo_bf(q.y); o[3] = hi_bf(q.y); }
__device__ __forceinline__ void rw_prep_a(const RwRegs& R, const RwConst& C, RwPrep& Q, LAS float* CL, LAS float* BONL, int tid) {
    const int sub = tid & 15;
#pragma unroll
    for (int i = 0; i < 2; ++i) {
        const int tl = (tid >> 4) + 32 * i;
        float r4[4], rp[4], k4[4], kp[4], v4[4], vp[4], av[4];
        unpack4(R.r[i], r4); unpack4(R.rp[i], rp); unpack4(R.k[i], k4); unpack4(R.kp[i], kp); unpack4(R.v[i], v4); unpack4(R.vp[i], vp); unpack4(R.lw[i], Q.lw[i]); unpack4(R.a[i], av);
        float n2 = 0.f, bsum = 0.f, kr[4];
#pragma unroll
        for (int e = 0; e < 4; ++e) {
            const float rs = r4[e] + (rp[e] - r4[e]) * C.mr[e], ks = k4[e] + (kp[e] - k4[e]) * C.mkk[e]; Q.vs[i][e] = v4[e] + (vp[e] - v4[e]) * C.mv[e];
            kr[e] = ks * C.kk_[e]; n2 += kr[e] * kr[e];
            Q.k2[i][e] = ks * (1.f + (av[e] - 1.f) * C.ka_[e]); Q.rs[i][e] = rs; bsum += rs * Q.k2[i][e] * C.rk_[e];
        }
        n2 = red16(n2); bsum = red16(bsum);
        const float inv = rsqrtf(fmaxf(n2, 1e-24f));
#pragma unroll
        for (int e = 0; e < 4; ++e) { Q.kk[i][e] = kr[e] * inv; Q.bq[i][e] = Q.kk[i][e] * av[e]; }
        *(LAS f32x4*)(CL + tl * 64 + 4 * sub) = (f32x4){Q.lw[i][0], Q.lw[i][1], Q.lw[i][2], Q.lw[i][3]};
        if (BONL != nullptr && sub == 0) BONL[tl] = bsum;
    }
}
__device__ __forceinline__ void rw_cumsum(LAS float* CL, LAS float* CS, LAS float* CT, int tid) {
    const int seg = tid >> 6, c = tid & 63;
    float cum[8]; float cs = 0.f;
#pragma unroll
    for (int i = 0; i < 8; ++i) { cs += CL[(seg * 8 + i) * 64 + c]; cum[i] = cs; }
    CS[seg * 64 + c] = cs;
    LBAR();
    float pre = 0.f, tot = 0.f;
#pragma unroll
    for (int s2 = 0; s2 < 8; ++s2) { const float v = CS[s2 * 64 + c]; tot += v; if (s2 < seg) pre += v; }
#pragma unroll
    for (int i = 0; i < 8; ++i) CL[(seg * 8 + i) * 64 + c] = pre + cum[i];
    if (seg == 0) CT[c] = tot;
    LBAR();
}
__device__ __forceinline__ void st4(LAS bf16_t* p, float a, float b, float c, float d) { u32x2 w; w.x = pk_bf16(a, b); w.y = pk_bf16(c, d); *(LAS u32x2*)p = w; }
__device__ __forceinline__ f32x4 tile64(f32x4 acc, const LAS bf16_t* first, int fr0, const LAS bf16_t* second, int sr0, int g4, int c16) {
#pragma unroll
    for (int st = 0; st < 2; ++st) acc = mfma16(*(const LAS bf16x8*)(first + (fr0 + c16) * RS + 32 * st + 8 * g4), *(const LAS bf16x8*)(second + (sr0 + c16) * RS + 32 * st + 8 * g4), acc);
    return acc;
}

__device__ __forceinline__ void rwkv_r1(LAS unsigned char* lds, int unit, const RwRegs& R, const RwConst& C, bf16_t* TG, bf16_t* CORR, bf16_t* NX, float* GAM, int tid) {
    const int lane = tid & 63, w = tid >> 6, g4 = lane >> 4, c16 = lane & 15, sub = tid & 15;
    LAS bf16_t* S0 = (LAS bf16_t*)lds;
    LAS bf16_t* KQ = S0; LAS bf16_t* BQ = S0 + SLOTE; LAS bf16_t* KT = S0 + 2 * SLOTE; LAS bf16_t* KQT = S0 + 3 * SLOTE; LAS bf16_t* BH = S0 + 4 * SLOTE; LAS bf16_t* KH = S0 + 5 * SLOTE; LAS bf16_t* VT = S0 + 6 * SLOTE;
    LAS bf16_t* PN = S0 + 7 * SLOTE; LAS bf16_t* PT = S0 + 8 * SLOTE; LAS bf16_t* TT = S0 + 9 * SLOTE; LAS bf16_t* LK = S0 + 10 * SLOTE; LAS bf16_t* W1T = S0 + 11 * SLOTE; LAS bf16_t* W2P = S0 + 12 * SLOTE; LAS bf16_t* W2T = S0 + 13 * SLOTE;
    LAS float* CL = (LAS float*)W1T;
    LAS float* CS = (LAS float*)(S0 + 14 * SLOTE); LAS float* CT = CS + 512;
    RwPrep Q;
    rw_prep_a(R, C, Q, CL, nullptr, tid);
    LBAR();
    rw_cumsum(CL, CS, CT, tid);
#pragma unroll
    for (int i = 0; i < 2; ++i) {
        const int tl = (tid >> 4) + 32 * i; const f32x4 cl = *(LAS f32x4*)(CL + tl * 64 + 4 * sub), tot = *(LAS f32x4*)(CT + 4 * sub);
        float kq[4], bq[4], kt[4], bh_[4], kh_[4];
#pragma unroll
        for (int e = 0; e < 4; ++e) { const float ein = __expf(cl[e]), eni = frcp(ein), eh = __expf(tot[e]) * eni;
            kq[e] = Q.kk[i][e] * ein * __expf(-Q.lw[i][e]); bq[e] = Q.bq[i][e] * eni; kt[e] = Q.k2[i][e] * eni; bh_[e] = Q.bq[i][e] * eh; kh_[e] = Q.k2[i][e] * eh; }
        asm volatile("" ::: "memory");
        st4(KQ + tl * RS + 4 * sub, kq[0], kq[1], kq[2], kq[3]); st4(BQ + tl * RS + 4 * sub, bq[0], bq[1], bq[2], bq[3]); st4(KT + tl * RS + 4 * sub, kt[0], kt[1], kt[2], kt[3]);
#pragma unroll
        for (int e = 0; e < 4; ++e) { KQT[(4 * sub + e) * RS + tl] = f2bf(kq[e]); BH[(4 * sub + e) * RS + tl] = f2bf(bh_[e]); KH[(4 * sub + e) * RS + tl] = f2bf(kh_[e]); VT[(4 * sub + e) * RS + tl] = f2bf(Q.vs[i][e]); }
    }
    if (tid < 64) GAM[(size_t)unit * 64 + tid] = __expf(CT[tid]);
    LBAR();
    const int rt = w >> 1, ct0 = 2 * (w & 1);
#pragma unroll
    for (int q = 0; q < 2; ++q) {
        const int ct = ct0 + q;
        {
            f32x4 acc = (f32x4){0.f, 0.f, 0.f, 0.f}, ack = acc; if (rt <= ct) { acc = tile64(acc, BQ, 16 * rt, KQ, 16 * ct, g4, c16); ack = tile64(ack, KT, 16 * rt, KQ, 16 * ct, g4, c16); }
            const int t = 16 * ct + c16, i0 = 16 * rt + 4 * g4; float l[4], lk[4];
#pragma unroll
            for (int e = 0; e < 4; ++e) { l[e] = (i0 + e < t) ? acc[e] : 0.f; lk[e] = (i0 + e < t) ? ack[e] : 0.f; }
            st4(PN + t * RS + i0, l[0], l[1], l[2], l[3]); st4(LK + t * RS + i0, lk[0], lk[1], lk[2], lk[3]);
            st4(TT + t * RS + i0, (i0 == t ? 1.f : 0.f) - l[0], (i0 + 1 == t ? 1.f : 0.f) - l[1], (i0 + 2 == t ? 1.f : 0.f) - l[2], (i0 + 3 == t ? 1.f : 0.f) - l[3]);
        }
        {
            f32x4 acc = (f32x4){0.f, 0.f, 0.f, 0.f}; if (ct <= rt) acc = tile64(acc, KQ, 16 * rt, BQ, 16 * ct, g4, c16);
            const int i = 16 * ct + c16, t0 = 16 * rt + 4 * g4; float l[4];
#pragma unroll
            for (int e = 0; e < 4; ++e) l[e] = (i < t0 + e) ? acc[e] : 0.f;
            st4(PT + i * RS + t0, l[0], l[1], l[2], l[3]);
        }
    }
    LBAR();
    for (int k = 1; k <= 6; ++k) {
        f32x4 pn[2], pt[2], tn[2];
#pragma unroll
        for (int q = 0; q < 2; ++q) {
            const int ct = ct0 + q;
            if (k <= 5) {
                pn[q] = tile64((f32x4){0.f, 0.f, 0.f, 0.f}, PT, 16 * rt, PN, 16 * ct, g4, c16);
                pt[q] = tile64((f32x4){0.f, 0.f, 0.f, 0.f}, PN, 16 * rt, PT, 16 * ct, g4, c16);
            }
            if (k >= 2) {
                const u32x2 told = *(const LAS u32x2*)(TT + (16 * ct + c16) * RS + 16 * rt + 4 * g4);
                f32x4 a = (f32x4){lo_bf(told.x), hi_bf(told.x), lo_bf(told.y), hi_bf(told.y)};
                tn[q] = tile64(a, PT, 16 * rt, TT, 16 * ct, g4, c16);
            }
        }
        LBAR();
#pragma unroll
        for (int q = 0; q < 2; ++q) {
            const int ct = ct0 + q;
            if (k <= 5) { st4(PN + (16 * ct + c16) * RS + 16 * rt + 4 * g4, pn[q][0], pn[q][1], pn[q][2], pn[q][3]); st4(PT + (16 * ct + c16) * RS + 16 * rt + 4 * g4, pt[q][0], pt[q][1], pt[q][2], pt[q][3]); }
            if (k >= 2) st4(TT + (16 * ct + c16) * RS + 16 * rt + 4 * g4, tn[q][0], tn[q][1], tn[q][2], tn[q][3]);
        }
        LBAR();
    }
    { const int rr = tid >> 3, ch8 = tid & 7; *(u32x4*)(TG + (size_t)unit * 4096 + rr * 64 + ch8 * 8) = *(const LAS u32x4*)(TT + rr * RS + ch8 * 8); }
#pragma unroll
    for (int q = 0; q < 2; ++q) { const int ct = ct0 + q;
        const f32x4 a1 = tile64((f32x4){0.f, 0.f, 0.f, 0.f}, TT, 16 * rt, KQT, 16 * ct, g4, c16); st4(W1T + (16 * ct + c16) * RS + 16 * rt + 4 * g4, a1[0], a1[1], a1[2], a1[3]);
        const f32x4 a2 = tile64((f32x4){0.f, 0.f, 0.f, 0.f}, LK, 16 * rt, VT, 16 * ct, g4, c16); st4(W2P + (16 * ct + c16) * RS + 16 * rt + 4 * g4, a2[0], a2[1], a2[2], a2[3]); }
    LBAR();
#pragma unroll
    for (int q = 0; q < 2; ++q) { const int ct = ct0 + q;
        const f32x4 a1 = tile64((f32x4){0.f, 0.f, 0.f, 0.f}, TT, 16 * rt, W2P, 16 * ct, g4, c16); st4(W2T + (16 * ct + c16) * RS + 16 * rt + 4 * g4, a1[0], a1[1], a1[2], a1[3]);
        const f32x4 a2 = tile64((f32x4){0.f, 0.f, 0.f, 0.f}, W1T, 16 * rt, BH, 16 * ct, g4, c16);
        u32x2 o; o.x = pk_bf16(a2[0], a2[1]); o.y = pk_bf16(a2[2], a2[3]); *(u32x2*)(CORR + (size_t)unit * 4096 + (16 * ct + c16) * 64 + 16 * rt + 4 * g4) = o; }
    LBAR();
#pragma unroll
    for (int q = 0; q < 2; ++q) { const int ct = ct0 + q;
        const f32x4 a1 = tile64((f32x4){0.f, 0.f, 0.f, 0.f}, KH, 16 * rt, VT, 16 * ct, g4, c16), a2 = tile64((f32x4){0.f, 0.f, 0.f, 0.f}, BH, 16 * rt, W2T, 16 * ct, g4, c16);
        u32x2 o; o.x = pk_bf16(a1[0] - a2[0], a1[1] - a2[1]); o.y = pk_bf16(a1[2] - a2[2], a1[3] - a2[3]); *(u32x2*)(NX + (size_t)unit * 4096 + (16 * ct + c16) * 64 + 16 * rt + 4 * g4) = o; }
    LBAR();
}

__device__ __forceinline__ void rwkv_r2(LAS unsigned char* lds, int gid  , const bf16_t* CORR, bf16_t* NX, const float* GAM, int lane, int wave) {
    const int bh = gid >> 2, vs = (gid & 3) * 16, ct = wave & 3, g4 = lane >> 4, c16 = lane & 15;
    LAS bf16_t* XB = (LAS bf16_t*)(lds + (wave >> 2) * 4 * 16 * RS * 2);
    f32x4 X = (f32x4){0.f, 0.f, 0.f, 0.f};
    constexpr int DEP = 8;
    u32x4 A[DEP][2]; u32x2 N[DEP]; f32x4 Gm[DEP];
    const bf16_t* cp0 = CORR + (size_t)bh * 64 * 4096 + (16 * ct + c16) * 64 + 8 * g4;
    bf16_t* np0 = NX + (size_t)bh * 64 * 4096 + (vs + c16) * 64 + 16 * ct + 4 * g4;
    const float* gp0 = GAM + (size_t)bh * 64 * 64 + 16 * ct + 4 * g4;
#pragma unroll
    for (int d = 0; d < DEP; ++d) { A[d][0] = *(const u32x4*)(cp0 + (size_t)d * 4096); A[d][1] = *(const u32x4*)(cp0 + (size_t)d * 4096 + 32); N[d] = *(const u32x2*)(np0 + (size_t)d * 4096); Gm[d] = *(const f32x4*)(gp0 + d * 64); }
    for (int c0 = 0; c0 < 64; c0 += DEP) {
#pragma unroll
        for (int d = 0; d < DEP; ++d) {
            const int ch = c0 + d;
            LAS bf16_t* XH = XB + (ch & 1) * 2 * 16 * RS; LAS bf16_t* XL = XH + 16 * RS;
            u32x2 h; h.x = pk_bf16(X[0], X[1]); h.y = pk_bf16(X[2], X[3]);
            const u32x2 nv2 = N[d];
            *(u32x2*)(np0 + (size_t)ch * 4096) = h;
            *(LAS u32x2*)(XH + c16 * RS + 16 * ct + 4 * g4) = h;
            st4(XL + c16 * RS + 16 * ct + 4 * g4, X[0] - lo_bf(h.x), X[1] - hi_bf(h.x), X[2] - lo_bf(h.y), X[3] - hi_bf(h.y));
            LBAR();
            f32x4 acc = (f32x4){0.f, 0.f, 0.f, 0.f};
#pragma unroll
            for (int st = 0; st < 2; ++st) { const bf16x8 bhf = *(const LAS bf16x8*)(XH + c16 * RS + 32 * st + 8 * g4), blf = *(const LAS bf16x8*)(XL + c16 * RS + 32 * st + 8 * g4);
                acc = mfma16(__builtin_bit_cast(bf16x8, A[d][st]), bhf, acc); acc = mfma16(__builtin_bit_cast(bf16x8, A[d][st]), blf, acc); }
            const f32x4 nv = (f32x4){lo_bf(nv2.x), hi_bf(nv2.x), lo_bf(nv2.y), hi_bf(nv2.y)};
            X = Gm[d] * X - acc + nv;
            if (ch + DEP < 64) { A[d][0] = *(const u32x4*)(cp0 + (size_t)(ch + DEP) * 4096); A[d][1] = *(const u32x4*)(cp0 + (size_t)(ch + DEP) * 4096 + 32); N[d] = *(const u32x2*)(np0 + (size_t)(ch + DEP) * 4096); Gm[d] = *(const f32x4*)(gp0 + (ch + DEP) * 64); }
        }
    }
}

__device__ __forceinline__ void rwkv_r3(LAS unsigned char* lds, int u0, int nu, const bf16_t* P0, const bf16_t* LO, const bf16_t* TG, const bf16_t* NX, const float* mu, const float* k_k, const float* k_a, const float* r_k,
                                        const float* gn_w, const float* gn_b, bf16_t* MIX, int tid) {
    const int lane = tid & 63, w = tid >> 6, g4 = lane >> 4, c16 = lane & 15, sub = tid & 15;
    LAS bf16_t* S0 = (LAS bf16_t*)lds;
    LAS bf16_t* KQ = S0; LAS bf16_t* RQ = S0 + SLOTE; LAS bf16_t* BQ = S0 + 2 * SLOTE; LAS bf16_t* KT = S0 + 3 * SLOTE; LAS bf16_t* VT = S0 + 4 * SLOTE;
    LAS bf16_t* LK = S0 + 5 * SLOTE; LAS bf16_t* AB = S0 + 6 * SLOTE; LAS bf16_t* AK = S0 + 7 * SLOTE; LAS bf16_t* GT = S0 + 8 * SLOTE; LAS bf16_t* UT = S0 + 9 * SLOTE; LAS bf16_t* XT = S0 + 10 * SLOTE;
    LAS float* CL = (LAS float*)LK;
    LAS float* CS = (LAS float*)(S0 + 11 * SLOTE); LAS float* CT = CS + 512; LAS float* BONL = CT + 64; LAS float* SM = BONL + 64;
    const int rt = w >> 1, ct0 = 2 * (w & 1);
    RwRegs Rc, Rn; u32x4 Tc[2], Tn[2], Xc, Xn; unsigned short gc[8], gnx[8];
    auto load_all = [&](int u, RwRegs& R, u32x4 (&Tf)[2], u32x4& Xi, unsigned short (&gq)[8]) {
        const int bh = u >> 6, ch = u & 63, b = bh >> 3, h = bh & 7;
        rw_load(R, bh, ch, P0, LO, tid);
        const bf16_t* tp = TG + (size_t)u * 4096 + (16 * rt + c16) * 64 + 8 * g4; Tf[0] = *(const u32x4*)tp; Tf[1] = *(const u32x4*)(tp + 32);
        Xi = *(const u32x4*)(NX + (size_t)u * 4096 + (tid >> 3) * 64 + (tid & 7) * 8);
#pragma unroll
        for (int q = 0; q < 2; ++q)
#pragma unroll
            for (int e = 0; e < 4; ++e) gq[q * 4 + e] = LO[((size_t)b * T + ch * 64 + 16 * rt + 4 * g4 + e) * LOW + 1024 + h * 64 + 16 * (ct0 + q) + c16];
    };
    load_all(u0, Rc, Tc, Xc, gc);
    for (int ui = 0; ui < nu; ++ui) {
        const int u = u0 + ui, bh = u >> 6, ch = u & 63, b = bh >> 3, h = bh & 7;
        if (ui + 1 < nu) load_all(u + 1, Rn, Tn, Xn, gnx);
        RwConst C; rw_consts(C, h, sub, mu, k_k, k_a, r_k);
        float gw[2], gb[2];
#pragma unroll
        for (int q = 0; q < 2; ++q) { gw[q] = gn_w[h * 64 + 16 * (ct0 + q) + c16]; gb[q] = gn_b[h * 64 + 16 * (ct0 + q) + c16]; }
        RwPrep Q;
        rw_prep_a(Rc, C, Q, CL, BONL, tid);
        *(LAS u32x4*)(XT + (tid >> 3) * RS + (tid & 7) * 8) = Xc;
        LBAR();
        rw_cumsum(CL, CS, CT, tid);
#pragma unroll
        for (int i = 0; i < 2; ++i) {
            const int tl = (tid >> 4) + 32 * i; const f32x4 cl = *(LAS f32x4*)(CL + tl * 64 + 4 * sub);
            float kq[4], rq[4], bq[4], kt[4];
#pragma unroll
            for (int e = 0; e < 4; ++e) { const float ein = __expf(cl[e]), eni = frcp(ein);
                kq[e] = Q.kk[i][e] * ein * __expf(-Q.lw[i][e]); rq[e] = Q.rs[i][e] * ein; bq[e] = Q.bq[i][e] * eni; kt[e] = Q.k2[i][e] * eni; }
            asm volatile("" ::: "memory");
            st4(KQ + tl * RS + 4 * sub, kq[0], kq[1], kq[2], kq[3]); st4(RQ + tl * RS + 4 * sub, rq[0], rq[1], rq[2], rq[3]);
            st4(BQ + tl * RS + 4 * sub, bq[0], bq[1], bq[2], bq[3]); st4(KT + tl * RS + 4 * sub, kt[0], kt[1], kt[2], kt[3]);
#pragma unroll
            for (int e = 0; e < 4; ++e) VT[(4 * sub + e) * RS + tl] = f2bf(Q.vs[i][e]);
        }
        LBAR();
#pragma unroll
        for (int j = 0; j < 6; ++j) {
            const int qi = w * 6 + j, mat = qi >> 4, tile = qi & 15, it = tile >> 2, tt = tile & 3;
            const LAS bf16_t* first = (mat == 1) ? BQ : KT; const LAS bf16_t* second = (mat == 0) ? KQ : RQ; LAS bf16_t* dst = (mat == 0) ? LK : (mat == 1) ? AB : AK;
            f32x4 acc = (f32x4){0.f, 0.f, 0.f, 0.f}; if (it <= tt) acc = tile64(acc, first, 16 * it, second, 16 * tt, g4, c16);
            const int t = 16 * tt + c16, i0 = 16 * it + 4 * g4; float l[4];
#pragma unroll
            for (int e = 0; e < 4; ++e) l[e] = ((mat == 0) ? (i0 + e < t) : (i0 + e <= t)) ? acc[e] : 0.f;
            st4(dst + t * RS + i0, l[0], l[1], l[2], l[3]);
        }
        LBAR();
#pragma unroll
        for (int q = 0; q < 2; ++q) { const int ct = ct0 + q;
            f32x4 acc = tile64((f32x4){0.f, 0.f, 0.f, 0.f}, KQ, 16 * rt, XT, 16 * ct, g4, c16); acc = tile64(acc, LK, 16 * rt, VT, 16 * ct, g4, c16);
            st4(GT + (16 * ct + c16) * RS + 16 * rt + 4 * g4, acc[0], acc[1], acc[2], acc[3]); }
        LBAR();
#pragma unroll
        for (int q = 0; q < 2; ++q) { const int ct = ct0 + q; f32x4 acc = (f32x4){0.f, 0.f, 0.f, 0.f};
#pragma unroll
            for (int st = 0; st < 2; ++st) acc = mfma16(__builtin_bit_cast(bf16x8, Tc[st]), *(const LAS bf16x8*)(GT + (16 * ct + c16) * RS + 32 * st + 8 * g4), acc);
            st4(UT + (16 * ct + c16) * RS + 16 * rt + 4 * g4, -acc[0], -acc[1], -acc[2], -acc[3]); }
        LBAR();
        f32x4 Yv[2];
#pragma unroll
        for (int q = 0; q < 2; ++q) { const int ct = ct0 + q;
            f32x4 acc = tile64((f32x4){0.f, 0.f, 0.f, 0.f}, RQ, 16 * rt, XT, 16 * ct, g4, c16); acc = tile64(acc, AB, 16 * rt, UT, 16 * ct, g4, c16); Yv[q] = tile64(acc, AK, 16 * rt, VT, 16 * ct, g4, c16); }
#pragma unroll
        for (int e = 0; e < 4; ++e) { const float s1 = red16(Yv[0][e] + Yv[1][e]), s2 = red16(Yv[0][e] * Yv[0][e] + Yv[1][e] * Yv[1][e]);
            if (c16 == 0) { SM[((w & 1) * 2 + 0) * 64 + 16 * rt + 4 * g4 + e] = s1; SM[((w & 1) * 2 + 1) * 64 + 16 * rt + 4 * g4 + e] = s2; } }
        LBAR();
#pragma unroll
        for (int e = 0; e < 4; ++e) {
            const int t = 16 * rt + 4 * g4 + e;
            const float mean = (SM[0 * 64 + t] + SM[2 * 64 + t]) * (1.f / 64.f), ex2 = (SM[1 * 64 + t] + SM[3 * 64 + t]) * (1.f / 64.f);
            const float rstd = rsqrtf(fmaxf(ex2 - mean * mean, 0.f) + 64e-5f), bon = BONL[t];
            const size_t row = (size_t)b * T + ch * 64 + t;
#pragma unroll
            for (int q = 0; q < 2; ++q) { const int v = 16 * (ct0 + q) + c16;
                const float o = ((Yv[q][e] - mean) * rstd * gw[q] + gb[q] + bon * bf2f(VT[v * RS + t])) * bf2f(gc[q * 4 + e]);
                MIX[row * D + 512 + h * 64 + v] = f2bf(o); }
        }
        LBAR();
        Rc = Rn; Tc[0] = Tn[0]; Tc[1] = Tn[1]; Xc = Xn;
#pragma unroll
        for (int e = 0; e < 8; ++e) gc[e] = gnx[e];
    }
}

__device__ __forceinline__ void compress_unit(LAS unsigned char* lds, int u, const bf16_t* P1, const bf16_t* W1T, const float* cbias, const float* w2k, const float* w2v, bf16_t* CMPK, bf16_t* CMPVT, int tid) {
    const int which = u >> 8, b = (u >> 6) & 3, g = (u >> 4) & 3, nb = u & 15, n0 = nb * 16;
    const int lane = tid & 63, w = tid >> 6, g4 = lane >> 4, c16 = lane & 15;
    LAS float* PART = (LAS float*)lds;
    LAS float* HID = PART + 8 * 16 * 64;
    f32x4 acc[4];
#pragma unroll
    for (int j = 0; j < 4; ++j) acc[j] = (f32x4){0.f, 0.f, 0.f, 0.f};
    const int n = n0 + c16; const bool valid = n < 255;
    const bf16_t* abase = P1 + ((size_t)b * T + 16 * (valid ? n : 0)) * P1W + 1024 + which * 256 + g * 64;
    const bf16_t* wbase = W1T + (size_t)which * 64 * 2048;
#pragma unroll
    for (int i = 0; i < 8; ++i) {
        const int ks = 8 * w + i, li = ks >> 1, d0 = 32 * (ks & 1) + 8 * g4;
        bf16x8 a = (bf16x8){0, 0, 0, 0, 0, 0, 0, 0};
        if (valid) a = *(const bf16x8*)(abase + (size_t)li * P1W + d0);
#pragma unroll
        for (int jt = 0; jt < 4; ++jt) { const bf16x8 bb = *(const bf16x8*)(wbase + (size_t)(16 * jt + c16) * 2048 + 32 * ks + 8 * g4); acc[jt] = mfma16(a, bb, acc[jt]); }
    }
#pragma unroll
    for (int jt = 0; jt < 4; ++jt)
#pragma unroll
        for (int rg = 0; rg < 4; ++rg) PART[(w * 16 + 4 * g4 + rg) * 64 + 16 * jt + c16] = acc[jt][rg];
    BLOCK_SYNC();
    {
        const int nn = tid >> 5, j2 = (tid & 31) * 2;
        float s0 = cbias[which * 64 + j2], s1 = cbias[which * 64 + j2 + 1];
#pragma unroll
        for (int w2 = 0; w2 < 8; ++w2) { s0 += PART[(w2 * 16 + nn) * 64 + j2]; s1 += PART[(w2 * 16 + nn) * 64 + j2 + 1]; }
        HID[nn * 64 + j2] = fgelu(s0); HID[nn * 64 + j2 + 1] = fgelu(s1);
    }
    BLOCK_SYNC();
    {
        const int nn = tid >> 5, d2 = (tid & 31) * 2; const float* w2 = which ? w2v : w2k;
        float o0 = 0.f, o1 = 0.f;
#pragma unroll 8
        for (int j = 0; j < 64; ++j) { const float hv = HID[nn * 64 + j]; o0 += hv * w2[j * 64 + d2]; o1 += hv * w2[j * 64 + d2 + 1]; }
        const int ng = n0 + nn; if (ng >= 255) { o0 = 0.f; o1 = 0.f; }
        if (which == 0) *(unsigned*)(CMPK + (((size_t)b * 4 + g) * 256 + ng) * 64 + d2) = pk_bf16(o0, o1);
        else { CMPVT[(((size_t)b * 4 + g) * 64 + d2) * 256 + ng] = f2bf(o0); CMPVT[(((size_t)b * 4 + g) * 64 + d2 + 1) * 256 + ng] = f2bf(o1); }
    }
    BLOCK_SYNC();
}
__device__ __forceinline__ void vtrans_item(LAS bf16_t* scr  , int it, const bf16_t* P1, bf16_t* VTS, bf16_t* VTW, int lane) {
    const int which = it >> 10, b = (it >> 8) & 3, g = (it >> 6) & 3, tt = it & 63;
    const bf16_t* src = P1 + ((size_t)b * T + tt * 64) * P1W + (which ? 2304 : 1792) + g * 64;
    bf16_t* dst = (which ? VTW : VTS) + (((size_t)b * 4 + g) * 64) * T + tt * 64;
#pragma unroll
    for (int i = 0; i < 8; ++i) { const int t = (lane >> 3) + 8 * i, ch = lane & 7; const u32x4 v = *(const u32x4*)(src + (size_t)t * P1W + ch * 8);
        LAS unsigned* d = (LAS unsigned*)(scr + t * 66 + ch * 8); d[0] = v.x; d[1] = v.y; d[2] = v.z; d[3] = v.w; }
    LDS_WAIT(); asm volatile("" ::: "memory");
#pragma unroll
    for (int i = 0; i < 8; ++i) { const int d = (lane >> 3) + 8 * i, t0 = (lane & 7) * 8;
        unsigned short e[8];
#pragma unroll
        for (int j = 0; j < 8; ++j) e[j] = scr[(t0 + j) * 66 + d];
        u32x4 o; o.x = e[0] | ((unsigned)e[1] << 16); o.y = e[2] | ((unsigned)e[3] << 16); o.z = e[4] | ((unsigned)e[5] << 16); o.w = e[6] | ((unsigned)e[7] << 16);
        *(u32x4*)(dst + (size_t)d * T + t0) = o; }
    LDS_WAIT(); asm volatile("" ::: "memory");
}

__device__ __forceinline__ int crow(int r, int hi) { return (r & 3) + 8 * (r >> 2) + 4 * hi; }
struct TileRegs { u32x4 k, v; };
__device__ __forceinline__ void tile_load(TileRegs& R, const bf16_t* kp, size_t kstride, const bf16_t* vp, size_t vstride, int tid) {
    const int ri = tid >> 3, ch = tid & 7;
    R.k = *(const u32x4*)(kp + (size_t)ri * kstride + ch * 8); R.v = *(const u32x4*)(vp + (size_t)ri * vstride + ch * 8);
}
__device__ __forceinline__ void tile_store(const TileRegs& R, LAS bf16_t* KB, LAS bf16_t* VB, int tid) {
    const int ri = tid >> 3, ch = tid & 7;
    *(LAS u32x4*)(KB + ri * 72 + ch * 8) = R.k; *(LAS u32x4*)(VB + ri * 72 + ch * 8) = R.v;
}
template <int MODE, bool MASKED>
__device__ __forceinline__ void attn_tile(const LAS bf16_t* KB, const LAS bf16_t* VB, const bf16x8 (&qf)[4], f32x16& o0, f32x16& o1, float& m, float& l,
                                          int tq, int kbase, float lb0, float lb1, const float slope2, float invl, LAS float* imp_row, LAS float* bsp_row, int jbase, int hq, int hh) {
    f32x16 p0, p1;
#pragma unroll
    for (int r = 0; r < 16; ++r) { const float cr = (float)(((r & 3) + 8 * (r >> 2)) * (MODE <= 1 ? 16 : 1)); p0[r] = fmaf(slope2, cr, lb0); p1[r] = fmaf(slope2, cr, lb1); }
#pragma unroll
    for (int s = 0; s < 4; ++s) {
        const bf16x8 a0 = *(const LAS bf16x8*)(KB + hq * 72 + 16 * s + 8 * hh), a1 = *(const LAS bf16x8*)(KB + (32 + hq) * 72 + 16 * s + 8 * hh);
        p0 = mfma32(a0, qf[s], p0); p1 = mfma32(a1, qf[s], p1);
    }
    const float NEG = -INFINITY;
    if (MASKED) {
#pragma unroll
        for (int r = 0; r < 16; ++r) {
            const int kr = crow(r, hh);
            bool v0, v1;
            if (MODE <= 1) { const int d0 = tq - 31 - 16 * (kbase + kr); v0 = d0 >= 0; v1 = d0 >= 512; }
            else { const int d0 = tq - (kbase + kr); if (MODE == 2) { v0 = d0 >= 0; v1 = d0 >= 32; } else { v0 = d0 >= 0 && d0 < 512; v1 = d0 >= 32 && d0 < 544; } }
            p0[r] = v0 ? p0[r] : NEG; p1[r] = v1 ? p1[r] : NEG;
        }
    }
    if (MODE == 1) {
        float sums[8];
#pragma unroll
        for (int r = 0; r < 16; ++r) { p0[r] = __builtin_amdgcn_exp2f(p0[r] - m) * invl; p1[r] = __builtin_amdgcn_exp2f(p1[r] - m) * invl; }
#pragma unroll
        for (int q4 = 0; q4 < 4; ++q4) { sums[q4] = (p0[4 * q4] + p0[4 * q4 + 1]) + (p0[4 * q4 + 2] + p0[4 * q4 + 3]); sums[4 + q4] = (p1[4 * q4] + p1[4 * q4 + 1]) + (p1[4 * q4 + 2] + p1[4 * q4 + 3]); }
        float osp[8];
#pragma unroll
        for (int q4 = 0; q4 < 4; ++q4) { osp[q4] = __shfl_xor(p0[4 * q4 + 3], 32); osp[4 + q4] = __shfl_xor(p1[4 * q4 + 3], 32); }
#pragma unroll
        for (int q4 = 0; q4 < 4; ++q4) {
            float v0, v1;
            if (hh) { v0 = sums[q4] + osp[q4]; v1 = sums[4 + q4] + osp[4 + q4]; }
            else { v0 = sums[q4] + (q4 ? osp[q4 - 1] : 0.f); v1 = sums[4 + q4] + osp[3 + q4]; }
            imp_row[jbase + 2 * q4 + hh] = v0; imp_row[jbase + 8 + 2 * q4 + hh] = v1;
        }
        if (hh) bsp_row[jbase >> 4] = p1[15];
        return;
    } else {
        float mx = fmaxf(p0[0], p1[0]);
#pragma unroll
        for (int r = 1; r < 16; ++r) mx = fmaxf(mx, fmaxf(p0[r], p1[r]));
        mx = fmaxf(mx, __shfl_xor(mx, 32));
        const float mn = fmaxf(m, mx);
        const float ms = (mn == NEG) ? 0.f : mn;
        const float alpha = __builtin_amdgcn_exp2f(m - ms);
        float ps = 0.f;
#pragma unroll
        for (int r = 0; r < 16; ++r) { p0[r] = __builtin_amdgcn_exp2f(p0[r] - ms); p1[r] = __builtin_amdgcn_exp2f(p1[r] - ms); ps += p0[r] + p1[r]; }
        l = l * alpha + ps; m = mn;
        if (__any(alpha != 1.f)) {
#pragma unroll
            for (int r = 0; r < 16; ++r) { o0[r] *= alpha; o1[r] *= alpha; }
        }
    }
    asm volatile("" ::: "memory");
#pragma unroll
    for (int ks = 0; ks < 4; ++ks) {
        if (ks == 2) asm volatile("" ::: "memory");
        u32x4 pk;
        if (ks < 2) { pk.x = pk_bf16(p0[8 * ks], p0[8 * ks + 1]); pk.y = pk_bf16(p0[8 * ks + 2], p0[8 * ks + 3]); pk.z = pk_bf16(p0[8 * ks + 4], p0[8 * ks + 5]); pk.w = pk_bf16(p0[8 * ks + 6], p0[8 * ks + 7]); }
        else { const int k2 = ks - 2; pk.x = pk_bf16(p1[8 * k2], p1[8 * k2 + 1]); pk.y = pk_bf16(p1[8 * k2 + 2], p1[8 * k2 + 3]); pk.z = pk_bf16(p1[8 * k2 + 4], p1[8 * k2 + 5]); pk.w = pk_bf16(p1[8 * k2 + 6], p1[8 * k2 + 7]); }
        const bf16x8 pf = __builtin_bit_cast(bf16x8, pk);
        const int koff = 32 * (ks >> 1) + 16 * (ks & 1) + 4 * hh;
#pragma unroll
        for (int dt = 0; dt < 2; ++dt) {
            const u32x2 lo = *(const LAS u32x2*)(VB + (32 * dt + hq) * 72 + koff), hi = *(const LAS u32x2*)(VB + (32 * dt + hq) * 72 + koff + 8);
            u32x4 a4; a4.x = lo.x; a4.y = lo.y; a4.z = hi.x; a4.w = hi.y;
            if (dt == 0) o0 = mfma32(__builtin_bit_cast(bf16x8, a4), pf, o0); else o1 = mfma32(__builtin_bit_cast(bf16x8, a4), pf, o1);
        }
    }
}

__device__ __forceinline__ void nsa_unit(LAS unsigned char* lds, int b, int g, int qt, const bf16_t* P1, const bf16_t* CMPK, const bf16_t* CMPVT, const bf16_t* VTS, const bf16_t* VTW, bf16_t* OUT, int tid, const int skip = 0) {
    asm volatile("" : "+v"(tid));
    const int lane = tid & 63, w = tid >> 6, r = w >> 1, th = w & 1, hq = lane & 31, hh = lane >> 5;
    const int h = g * 4 + r, q0 = qt * 64, tokl = 32 * th + hq, tq = q0 + tokl;
    const size_t grow = (size_t)b * T + tq;
    LAS bf16_t* KB0 = (LAS bf16_t*)lds; LAS bf16_t* VB0 = KB0 + 2 * 64 * 72;
    LAS float* IMP = (LAS float*)(lds + 36864);
    LAS unsigned* SELM = (LAS unsigned*)(lds + 36864 + 66560);
    LAS unsigned* UNI = SELM + 128;
    LAS float* BSP = (LAS float*)(UNI + 8);
    const float slope2 = exp2f(-0.5f * (float)(h + 1)) * LOG2E;
    constexpr float C1 = 0.125f * LOG2E;
    bf16x8 qf[4];
#pragma unroll
    for (int s = 0; s < 4; ++s) { const u32x4 qq = *(const u32x4*)(P1 + grow * P1W + h * 64 + 16 * s + 8 * hh);
        u32x4 o; o.x = pk_bf16(lo_bf(qq.x) * C1, hi_bf(qq.x) * C1); o.y = pk_bf16(lo_bf(qq.y) * C1, hi_bf(qq.y) * C1); o.z = pk_bf16(lo_bf(qq.z) * C1, hi_bf(qq.z) * C1); o.w = pk_bf16(lo_bf(qq.w) * C1, hi_bf(qq.w) * C1);
        qf[s] = __builtin_bit_cast(bf16x8, o); }
#define NSA_GATE(br) fsigmoid(bf2f(P1[((size_t)b * T + tq) * P1W + 2560 + h * 3 + (br)]))
    if (tid < 2) UNI[tid] = 0u;
    LAS float* OAL = IMP + tid;
    TileRegs R;
    const size_t bg = (size_t)b * 4 + g;
    const int nmax = (q0 + 63 - 31) / 16;
    const int nct = nmax / 64 + 1;
    float cm = -INFINITY, cl = 0.f;
    f32x16 o0, o1;
#pragma unroll
    for (int i = 0; i < 16; ++i) { o0[i] = 0.f; o1[i] = 0.f; }
    for (int pass = 0; pass < 2; ++pass) {
        float invl = 0.f;
        if (pass == 1) { const float lt = cl + __shfl_xor(cl, 32); invl = lt > 0.f ? 1.f / lt : 0.f; if (cm == -INFINITY) cm = 0.f; }
        tile_load(R, CMPK + (bg * 256 + 64 * (nct - 1)) * 64, 64, CMPVT + bg * 64 * 256 + 64 * (nct - 1), 256, tid);
        BLOCK_SYNC();
        tile_store(R, KB0, VB0, tid);
        BLOCK_SYNC();
        for (int ci = 0; ci < nct; ++ci) {
            const int ct = nct - 1 - ci;
            if (ci + 1 < nct) tile_load(R, CMPK + (bg * 256 + 64 * (ct - 1)) * 64, 64, CMPVT + bg * 64 * 256 + 64 * (ct - 1), 256, tid);
            const LAS bf16_t* KB = KB0 + (ci & 1) * 64 * 72; const LAS bf16_t* VB = VB0 + (ci & 1) * 64 * 72;
            const float lb0 = -slope2 * (float)(tq - 31 - 16 * (64 * ct + 4 * hh)), lb1 = lb0 + 512.f * slope2;
            if (pass == 0) attn_tile<0, true>(KB, VB, qf, o0, o1, cm, cl, tq, 64 * ct, lb0, lb1, slope2, 0.f, nullptr, nullptr, 0, hq, hh);
            else attn_tile<1, true>(KB, VB, qf, o0, o1, cm, cl, tq, 64 * ct, lb0, lb1, slope2, invl, IMP + (r * 64 + tokl) * 65, BSP + (r * 64 + tokl) * 4, 16 * ct, hq, hh);
            if (ci + 1 < nct) tile_store(R, KB0 + ((ci + 1) & 1) * 64 * 72, VB0 + ((ci + 1) & 1) * 64 * 72, tid);
            BLOCK_SYNC();
        }
    }
    {
        const int tok = tid >> 3, part = tid & 7;
        float scv[8];
#pragma unroll
        for (int jj = 0; jj < 8; ++jj) { const int j = 8 * part + jj;
            const bool valid = j <= qt; const bool forced = (j == 0) || (valid && (qt - j) < 2);
            float im = 0.f;
            if (valid) { im = ((IMP[(0 * 64 + tok) * 65 + j] + IMP[(1 * 64 + tok) * 65 + j]) + IMP[(2 * 64 + tok) * 65 + j]) + IMP[(3 * 64 + tok) * 65 + j];
                if ((j & 15) == 0 && j > 0) { const int c1 = (j >> 4) - 1; im += ((BSP[(0 * 64 + tok) * 4 + c1] + BSP[(1 * 64 + tok) * 4 + c1]) + BSP[(2 * 64 + tok) * 4 + c1]) + BSP[(3 * 64 + tok) * 4 + c1]; } }
            scv[jj] = valid ? im + (forced ? 100.f : 0.f) : -100.f; }
        unsigned mlo = 0u, mhi = 0u;
        for (int it = 0; it < 8; ++it) {
            float bv = scv[0]; int bj = 0;
#pragma unroll
            for (int jj = 1; jj < 8; ++jj) if (scv[jj] > bv) { bv = scv[jj]; bj = jj; }
            bj += 8 * part;
#pragma unroll
            for (int o = 1; o < 8; o <<= 1) { const float ov = __shfl_xor(bv, o); const int oj = __shfl_xor(bj, o); if (ov > bv || (ov == bv && oj < bj)) { bv = ov; bj = oj; } }
            if ((bj >> 3) == part) {
#pragma unroll
                for (int jj = 0; jj < 8; ++jj) if (jj == (bj & 7)) scv[jj] = -INFINITY;
            }
            if (bj <= qt) { if (bj < 32) mlo |= 1u << bj; else mhi |= 1u << (bj - 32); }
        }
        if (part == 0) { SELM[tok * 2] = mlo; SELM[tok * 2 + 1] = mhi; atomicOr((unsigned*)(UNI), mlo); atomicOr((unsigned*)(UNI + 1), mhi); }
    }
    BLOCK_SYNC();
    { const float ltc = cl + __shfl_xor(cl, 32); const float gate0 = ltc > 0.f ? NSA_GATE(0) / ltc : 0.f;
#pragma unroll
    for (int i = 0; i < 16; ++i) { OAL[i * 512] = gate0 * o0[i]; OAL[(16 + i) * 512] = gate0 * o1[i]; } }
    const unsigned mylo = SELM[tokl * 2], myhi = SELM[tokl * 2 + 1];
    unsigned long long uni = ((unsigned long long)UNI[1] << 32) | UNI[0];
    uni = ((unsigned long long)__builtin_amdgcn_readfirstlane((unsigned)(uni >> 32)) << 32) | (unsigned)__builtin_amdgcn_readfirstlane((unsigned)uni);
    if (!(skip & 2)) {
        float sm = -INFINITY, sl = 0.f;
#pragma unroll
        for (int i = 0; i < 16; ++i) { o0[i] = 0.f; o1[i] = 0.f; }
        const bf16_t* kcol = P1 + (size_t)b * T * P1W + 1536 + g * 64; const bf16_t* vrow = VTS + bg * 64 * T;
        unsigned long long rem = uni;
        int j = 63 - __builtin_clzll(rem); rem &= ~(1ull << j);
        tile_load(R, kcol + (size_t)64 * j * P1W, P1W, vrow + 64 * j, T, tid);
        tile_store(R, KB0, VB0, tid);
        BLOCK_SYNC();
        int pb = 0;
        for (;;) {
            const bool more = rem != 0ull; int jn = 0;
            if (more) { jn = 63 - __builtin_clzll(rem); rem &= ~(1ull << jn); tile_load(R, kcol + (size_t)64 * jn * P1W, P1W, vrow + 64 * jn, T, tid); }
            const bool sb = j < 32 ? ((mylo >> j) & 1u) : ((myhi >> (j - 32)) & 1u);
            const float lb0 = sb ? -slope2 * (float)(tq - 64 * j - 4 * hh) : -INFINITY, lb1 = lb0 + 32.f * slope2;
            if (j == qt) attn_tile<2, true>(KB0 + pb * 64 * 72, VB0 + pb * 64 * 72, qf, o0, o1, sm, sl, tq, 64 * j, lb0, lb1, slope2, 0.f, nullptr, nullptr, 0, hq, hh);
            else attn_tile<2, false>(KB0 + pb * 64 * 72, VB0 + pb * 64 * 72, qf, o0, o1, sm, sl, tq, 64 * j, lb0, lb1, slope2, 0.f, nullptr, nullptr, 0, hq, hh);
            if (more) tile_store(R, KB0 + (pb ^ 1) * 64 * 72, VB0 + (pb ^ 1) * 64 * 72, tid);
            BLOCK_SYNC();
            if (!more) break;
            j = jn; pb ^= 1;
        }
        const float lt = sl + __shfl_xor(sl, 32); const float scl = lt > 0.f ? NSA_GATE(1) / lt : 0.f;
#pragma unroll
        for (int i = 0; i < 16; ++i) { OAL[i * 512] += scl * o0[i]; OAL[(16 + i) * 512] += scl * o1[i]; }
    }
    if (!(skip & 4)) {
        float sm = -INFINITY, sl = 0.f;
#pragma unroll
        for (int i = 0; i < 16; ++i) { o0[i] = 0.f; o1[i] = 0.f; }
        const bf16_t* kcol = P1 + (size_t)b * T * P1W + 2048 + g * 64; const bf16_t* vrow = VTW + bg * 64 * T;
        const int jlo = qt >= 8 ? qt - 8 : 0;
        tile_load(R, kcol + (size_t)64 * qt * P1W, P1W, vrow + 64 * qt, T, tid);
        tile_store(R, KB0, VB0, tid);
        BLOCK_SYNC();
        for (int j = qt; j >= jlo; --j) {
            const int pb = (qt - j) & 1;
            if (j > jlo) tile_load(R, kcol + (size_t)64 * (j - 1) * P1W, P1W, vrow + 64 * (j - 1), T, tid);
            const float lb0 = -slope2 * (float)(tq - 64 * j - 4 * hh), lb1 = lb0 + 32.f * slope2;
            if (j == qt || j == qt - 8) attn_tile<3, true>(KB0 + pb * 64 * 72, VB0 + pb * 64 * 72, qf, o0, o1, sm, sl, tq, 64 * j, lb0, lb1, slope2, 0.f, nullptr, nullptr, 0, hq, hh);
            else attn_tile<3, false>(KB0 + pb * 64 * 72, VB0 + pb * 64 * 72, qf, o0, o1, sm, sl, tq, 64 * j, lb0, lb1, slope2, 0.f, nullptr, nullptr, 0, hq, hh);
            if (j > jlo) tile_store(R, KB0 + (pb ^ 1) * 64 * 72, VB0 + (pb ^ 1) * 64 * 72, tid);
            BLOCK_SYNC();
        }
        const float lt = sl + __shfl_xor(sl, 32); const float scl = lt > 0.f ? NSA_GATE(2) / lt : 0.f;
#pragma unroll
        for (int i = 0; i < 16; ++i) { o0[i] = OAL[i * 512] + scl * o0[i]; o1[i] = OAL[(16 + i) * 512] + scl * o1[i]; }
    }
    const f32x16& oa0 = o0; const f32x16& oa1 = o1;
    bf16_t* op = OUT + ((size_t)b * T + tq) * D + h * 64;
#pragma unroll
    for (int q4 = 0; q4 < 4; ++q4) {
        u32x2 w0; w0.x = pk_bf16(oa0[4 * q4], oa0[4 * q4 + 1]); w0.y = pk_bf16(oa0[4 * q4 + 2], oa0[4 * q4 + 3]);
        u32x2 w1; w1.x = pk_bf16(oa1[4 * q4], oa1[4 * q4 + 1]); w1.y = pk_bf16(oa1[4 * q4 + 2], oa1[4 * q4 + 3]);
        *(u32x2*)(op + 8 * q4 + 4 * hh) = w0; *(u32x2*)(op + 32 + 8 * q4 + 4 * hh) = w1;
    }
    BLOCK_SYNC();
}

#define XB_TMO      128
#define XB_XCNT(j)  (256  + 64 * (j))
#define XB_XSUB(j)  (1280 + 64 * (j))
#define XB_XGEN(j)  (2304 + 64 * (j))
#define XB_TOP      3328
#define XB_TOPGEN   3392
#define XCD_BAR_WORDS 3456
#define XB_SPIN_CAP (1u << 18)

__device__ __forceinline__ unsigned xb_ld(unsigned* p)              { return __hip_atomic_load(p, __ATOMIC_RELAXED, __HIP_MEMORY_SCOPE_AGENT); }
__device__ __forceinline__ unsigned xb_add(unsigned* p, unsigned v) { return __hip_atomic_fetch_add(p, v, __ATOMIC_RELAXED, __HIP_MEMORY_SCOPE_AGENT); }
__device__ __forceinline__ unsigned xb_xcc_id() { return (unsigned)__builtin_amdgcn_s_getreg((3 << 11) | 20) & 0xFu; }
#define XB_SPIN(cond, bar) do { unsigned _sp = 0; while (cond) { __builtin_amdgcn_s_sleep(1); \
    if ((++_sp & 255u) == 0u) { if (xb_ld(&(bar)[XB_TMO])) break; if (_sp > XB_SPIN_CAP) { atomicAdd(&(bar)[XB_TMO], 1u); break; } } } } while (0)

struct XcdBarrier {
    unsigned* bar; unsigned x;
    volatile LAS unsigned* st;
};

__device__ __forceinline__ XcdBarrier xcd_barrier_post(unsigned* bar, volatile LAS unsigned* st) {
    XcdBarrier b; b.bar = bar; b.x = xb_xcc_id(); b.st = st;
    if (threadIdx.x == 0) (void)xb_add(&bar[XB_XCNT(b.x)], 1u);
    return b;
}
__device__ __forceinline__ void xcd_barrier_complete(unsigned* bar, unsigned x, unsigned& nloc, unsigned& nx) {
    const unsigned G = gridDim.x * gridDim.y * gridDim.z;
    unsigned sum, cnt, mine, sp = 0u;
    for (;;) {
        sum = 0u; cnt = 0u; mine = 0u;
#pragma unroll
        for (unsigned j = 0; j < 16; ++j) { const unsigned c = xb_ld(&bar[XB_XCNT(j)]); sum += c; cnt += (c > 0u) ? 1u : 0u; mine = (j == x) ? c : mine; }
        if (sum == G) break;
        __builtin_amdgcn_s_sleep(1);
        if ((++sp & 255u) == 0u) { if (xb_ld(&bar[XB_TMO])) break; if (sp > XB_SPIN_CAP) { atomicAdd(&bar[XB_TMO], 1u); break; } }
    }
    nloc = mine > 0u ? mine : 1u; nx = cnt > 0u ? cnt : 1u;
}

__device__ __forceinline__ void xcd_barrier(const XcdBarrier& b) {
    asm volatile("s_waitcnt vmcnt(0)" ::: "memory");
    __syncthreads();
    if (threadIdx.x == 0) {
        unsigned* bar = b.bar;
        __builtin_amdgcn_s_waitcnt(0);
        unsigned nloc = b.st[0], nx = b.st[1];
        if (nloc == 0u) { xcd_barrier_complete(bar, b.x, nloc, nx); b.st[0] = nloc; b.st[1] = nx; }
        const unsigned old = xb_add(&bar[XB_XSUB(b.x)], 1u);
        const unsigned gen = old / nloc;
        if (old + 1u == (gen + 1u) * nloc) {
            __builtin_amdgcn_fence(__ATOMIC_RELEASE, "agent");
            asm volatile("s_waitcnt vmcnt(0)" ::: "memory");
            const unsigned og = xb_add(&bar[XB_TOP], 1u);
            const unsigned tg = og / nx;
            if (og + 1u == (tg + 1u) * nx) xb_add(&bar[XB_TOPGEN], 1u);
            else XB_SPIN(xb_ld(&bar[XB_TOPGEN]) == tg, bar);
            __builtin_amdgcn_fence(__ATOMIC_ACQUIRE, "agent");
            xb_add(&bar[XB_XGEN(b.x)], 1u);
            asm volatile("s_waitcnt vmcnt(0)" ::: "memory");
        } else {
            XB_SPIN(xb_ld(&bar[XB_XGEN(b.x)]) == gen, bar);
            __builtin_amdgcn_fence(__ATOMIC_ACQUIRE, "agent");
            asm volatile("s_waitcnt vmcnt(0)" ::: "memory");
        }
    }
    __syncthreads();
}


#ifndef STOP_AFTER
#define STOP_AFTER (-1)
#endif
constexpr size_t WS_HASH = 250 * MiB;
__device__ __forceinline__ void dbg_hash_region(const unsigned char* base, size_t nbytes, unsigned* HB, int gtid, int NT, bool first) {
    const unsigned* p = (const unsigned*)base; const size_t nw = nbytes / 4;
    for (int i = gtid; i < (1 << 20); i += NT) { unsigned h = first ? 0u : HB[i]; for (size_t j = i; j < nw; j += (1u << 20)) h = h * 31u + p[j]; HB[i] = h; }
}
#define DBG_STOP(k, b0, n0, b1, n1) do { if (STOP_AFTER == (k)) { const int gt_ = bid * NTHREADS + (int)threadIdx.x, NT_ = G * NTHREADS; unsigned* HB_ = (unsigned*)(ws + WS_HASH); \
        if ((n0) > 0) dbg_hash_region((const unsigned char*)(b0), (n0), HB_, gt_, NT_, true); if ((n1) > 0) dbg_hash_region((const unsigned char*)(b1), (n1), HB_, gt_, NT_, false); \
        grid.sync(); if ((n0) > 0) for (int i_ = gt_; i_ < M * D; i_ += NT_) P.out[i_] = (float)(HB_[i_ & ((1 << 20) - 1)] & 0xfffffu); return; } } while (0)

__global__ void __launch_bounds__(NTHREADS, 2) mega_fwd(Ptrs P) {
    extern __shared__ __attribute__((aligned(16))) unsigned char lds_raw[];
    LAS unsigned char* lds = (LAS unsigned char*)lds_raw;
    cg::grid_group grid = cg::this_grid();
    { volatile LAS unsigned* MISC = (volatile LAS unsigned*)(lds + LDS_MISC);
    if (threadIdx.x < 8) MISC[threadIdx.x] = 0u;
    __syncthreads();
    (void)xcd_barrier_post((unsigned*)(P.ws + WS_CTL) + 4096, MISC); }
    const int bid = blockIdx.x, G = gridDim.x, NGW = G * NWAVES;
#define TIDS() int tid = threadIdx.x; asm volatile("" : "+v"(tid)); const int lane = tid & 63, wave = __builtin_amdgcn_readfirstlane(tid >> 6), gw = bid * NWAVES + wave; (void)lane; (void)gw;
    unsigned char* ws = P.ws;
    const float* x = P.in[0];
    float* X = P.out;
    float* MOD = (float*)(ws + WS_MOD);
    bf16_t* HN = (bf16_t*)(ws + WS_HN); bf16_t* MIX = HN;
    bf16_t* P0 = (bf16_t*)(ws + WS_P0); bf16_t* LI = (bf16_t*)(ws + WS_LI); bf16_t* LO = (bf16_t*)P.out;
    bf16_t* TG = (bf16_t*)(ws + WS_TG);
    bf16_t* H = (bf16_t*)(ws + WS_H); bf16_t* P1 = (bf16_t*)(ws + WS_P1);
    bf16_t* VTS = (bf16_t*)(ws + WS_VTS); bf16_t* VTW = (bf16_t*)(ws + WS_VTW); bf16_t* CMPK = (bf16_t*)(ws + WS_CMPK); bf16_t* CMPVT = (bf16_t*)(ws + WS_CMPVT);
#define CG_SYNC() do { asm volatile("s_waitcnt vmcnt(0) lgkmcnt(0)" ::: "memory"); grid.sync(); } while (0)
#define GRID_SYNC() do { XcdBarrier xb_; xb_.bar = (unsigned*)(P.ws + WS_CTL) + 4096; xb_.x = xb_xcc_id(); xb_.st = (volatile LAS unsigned*)(lds + LDS_MISC); xcd_barrier(xb_); } while (0)
#ifndef PHMASK
#define PHMASK 0xffffffffu
#endif
#define PH(n) (((PHMASK) >> (n)) & 1u)
#ifndef REPMASK
#define REPMASK 0u
#endif
#ifndef NSA_SKIP
#define NSA_SKIP 0
#endif
#ifndef REPSEL
#define REPSEL 0
#endif
#define NREP(n) ((((REPMASK) >> (n)) & 1u) ? 2 : 1)
#define GEMM(EpiT, E, Aptr, Bptr, Mrows, Ncols, Kdim, arows, nMt) do { pg8::Gemm g_{(Aptr), (Bptr), (Mrows), (Ncols), (Kdim), (arows)}; pg8::StaticOrder S_; S_.init_tiles((nMt), (Ncols) / 256, G, bid); \
        pg8::gemm_phase<EpiT, pg8::StaticOrder, true, true>(lds, g_, S_, (E)); } while (0)

    for (int rep_ = 0; rep_ < NREP(0); ++rep_) { if (rep_) GRID_SYNC(); TIDS();
    if (PH(0)) prologue(P, lds, tid, lane, wave, bid, G, false);
    }
    CG_SYNC(); DBG_STOP(0, ws + WS_MOD, WS_HNA - WS_MOD, ws, 0);
    for (int rep_ = 0; rep_ < NREP(1); ++rep_) { if (rep_) GRID_SYNC(); TIDS();
    if (PH(1)) norm_phase(x, P.in[4], MOD, 0, D, HN, nullptr, gw, NGW, lane);
    }
    GRID_SYNC(); DBG_STOP(1, ws + WS_HN, (size_t)M * D * 2, ws, 0);
    for (int rep_ = 0; rep_ < NREP(2); ++rep_) { if (rep_) GRID_SYNC(); TIDS();
    if (PH(2)) { EpiStore E{P0, P0W, P0W}; GEMM(EpiStore, E, HN, (const bf16_t*)(ws + WS_WEVIN), M, P0W, D, 256, 64); }
    }
    GRID_SYNC(); DBG_STOP(2, ws + WS_P0, (size_t)M * P0W * 2, ws, 0);
    for (int rep_ = 0; rep_ < NREP(3); ++rep_) { if (rep_) GRID_SYNC(); TIDS();
    if (PH(3)) lora_in_phase(P0, P.in[11], LI, gw, NGW, lane);
    }
    GRID_SYNC(); DBG_STOP(3, ws + WS_LI, (size_t)M * LIW * 2, ws, 0);
    for (int rep_ = 0; rep_ < NREP(4); ++rep_) { if (rep_) GRID_SYNC(); TIDS();
    if (PH(4)) { EpiLora E{LO, P.in[15], P.in[17], P.in[13]}; GEMM(EpiLora, E, LI, (const bf16_t*)(ws + WS_WLORA), M, LOW, LIW, 256, 64); }
    }
    GRID_SYNC(); DBG_STOP(4, (unsigned char*)P.out, (size_t)M * LOW * 2, ws, 0);
    { TIDS();
    bf16_t* GU = (bf16_t*)(ws + WS_GU); bf16_t* GS = (bf16_t*)(ws + WS_GS); float* GD = (float*)(ws + WS_GD);
    if (bid >= 128 && PH(6)) gla_part12(lds, bid - 128, G - 128, P0, LO, GU, GS, GD, (unsigned*)(ws + WS_CTL) + 8192, tid);
    if (PH(5)) {
        const int u0 = bid < 128 ? bid * 10 : 1280 + (bid - 128) * 6, nu = bid < 128 ? 10 : 6;
        RwRegs Rc, Rn; RwConst C;
        rw_load(Rc, u0 >> 6, u0 & 63, P0, LO, tid);
        for (int i = 0; i < nu; ++i) {
            const int u = u0 + i;
            if (i + 1 < nu) rw_load(Rn, (u + 1) >> 6, (u + 1) & 63, P0, LO, tid);
            rw_consts(C, (u >> 6) & 7, tid & 15, P.in[11], P.in[20], P.in[21], P.in[22]);
            rwkv_r1(lds, u, Rc, C, TG, (bf16_t*)(ws + WS_RCORR), (bf16_t*)(ws + WS_RNX), (float*)(ws + WS_RGAM), tid);
            Rc = Rn;
        }
    }
    }
    GRID_SYNC(); DBG_STOP(5, ws + WS_TG, (size_t)16 * MiB, ws + WS_RNX, (size_t)33 * MiB);
    { TIDS();
    if (bid < 64) { if (PH(5)) rwkv_r2(lds, bid * 2 + (wave >> 2), (const bf16_t*)(ws + WS_RCORR), (bf16_t*)(ws + WS_RNX), (const float*)(ws + WS_RGAM), lane, wave); }
    else if (bid >= 128 && PH(6)) gla_part3(lds, bid - 128, G - 128, P0, LO, P.in[14], (const bf16_t*)(ws + WS_GS), MIX, tid);
    }
    GRID_SYNC(); DBG_STOP(6, ws + WS_RNX, (size_t)16 * MiB, ws, 0);
    for (int rep_ = 0; rep_ < NREP(6); ++rep_) { if (rep_) GRID_SYNC(); TIDS();
    if (PH(5)) rwkv_r3(lds, bid * 8, 8, P0, LO, TG, (const bf16_t*)(ws + WS_RNX), P.in[11], P.in[20], P.in[21], P.in[22], P.in[23], P.in[24], MIX, tid);
    }
    GRID_SYNC();
    for (int rep_ = 0; rep_ < NREP(8); ++rep_) { if (rep_) GRID_SYNC(); TIDS();
    if (PH(8)) { EpiRes E{x, X, MOD + 2 * D}; GEMM(EpiRes, E, MIX, (const bf16_t*)(ws + WS_WEVOUT), M, D, D, 256, 64); }
    }
    GRID_SYNC(); DBG_STOP(7, ws, 0, ws, 0);
    for (int layer = 0; layer < 2; ++layer) {
        const float* modl = MOD + (size_t)layer * NB * 6144;
        if (layer == 1) {
            for (int rep_ = 0; rep_ < NREP(16); ++rep_) { if (rep_) GRID_SYNC(); TIDS();
            if (PH(16)) norm_phase(X, P.in[4] + D, modl, 0, D, HN, nullptr, gw, NGW, lane);
            }
            GRID_SYNC(); DBG_STOP(11, ws + WS_HN, (size_t)M * D * 2, ws, 0);
            for (int rep_ = 0; rep_ < NREP(13); ++rep_) { if (rep_) GRID_SYNC(); TIDS();
            if (PH(13)) { EpiStore E{P1, P1W, P1W}; GEMM(EpiStore, E, HN, (const bf16_t*)(ws + WS_WODIN), M, P1W, D, 256, 64); }
            }
            GRID_SYNC(); DBG_STOP(12, ws + WS_P1, (size_t)M * P1W * 2, ws, 0);
            for (int rep_ = 0; rep_ < NREP(9); ++rep_) { if (rep_) GRID_SYNC(); TIDS();
            if (PH(9)) for (int u = bid; u < 512; u += G) compress_unit(lds, u, P1, (const bf16_t*)(ws + WS_W1T), (const float*)(ws + WS_CBIAS), P.in[29], P.in[32], CMPK, CMPVT, tid);
            }
            for (int rep_ = 0; rep_ < NREP(10); ++rep_) { if (rep_) GRID_SYNC(); TIDS();
            if (PH(10)) for (int it = gw; it < 2048; it += NGW) vtrans_item((LAS bf16_t*)(lds + 40960 + wave * 8448), it, P1, VTS, VTW, lane);
            }
            GRID_SYNC(); DBG_STOP(13, ws + WS_VTS, WS_CMPVT + 512 * 1024 - WS_VTS, ws, 0);
            for (int rep_ = 0; rep_ < NREP(11); ++rep_) { if (rep_) GRID_SYNC(); TIDS();
            if (PH(11)) for (int vb = bid; vb < 256; vb += G) { const int q = vb & 63, s = (vb >> 6) & 3;
              for (int i = 0; i < 4; ++i) { const int bgi = 4 * s + i; const int qq = (i & 2) ? ((q + 32) & 63) : q; const int qt = (i & 1) ? 63 - qq : qq;
                  nsa_unit(lds, bgi >> 2, bgi & 3, qt, P1, CMPK, CMPVT, VTS, VTW, MIX, tid, (NREP(11) == 2 && rep_ == 0) ? NSA_SKIP : 0); } }
            }
            GRID_SYNC(); DBG_STOP(14, ws + WS_HN, (size_t)M * D * 2, ws, 0);
            for (int rep_ = 0; rep_ < NREP(14); ++rep_) { if (rep_) GRID_SYNC(); TIDS();
            if (PH(14)) { EpiRes E{X, X, modl + 2 * D}; GEMM(EpiRes, E, MIX, (const bf16_t*)(ws + WS_WODOUT), M, D, D, 256, 64); }
            }
            GRID_SYNC(); DBG_STOP(15, ws, 0, ws, 0);
        }
        for (int rep_ = 0; rep_ < NREP(16); ++rep_) { if (rep_) GRID_SYNC(); TIDS();
        if (PH(16)) norm_phase(X, P.in[5] + layer * D, modl, 3 * D, 4 * D, HN, nullptr, gw, NGW, lane);
        if (layer == 0 && PH(0)) prologue(P, lds, tid, lane, wave, bid, G, true);
        }
        GRID_SYNC(); DBG_STOP(8 + 8 * layer, ws + WS_HN, (size_t)M * D * 2, ws, 0);
        for (int rep_ = 0; rep_ < NREP(12); ++rep_) { if (rep_) GRID_SYNC(); TIDS();
        if (PH(12)) { EpiConv E{H, P.in[7] + (size_t)layer * 3 * F, P.in[8] + (size_t)layer * F, (LAS float*)(lds + LDS_HALO)};
          GEMM(EpiConv, E, HN - 2 * D, (const bf16_t*)(ws + WS_WUP) + (size_t)layer * 2 * F * D, M, 2 * F, D, 254, 65); }
        }
        GRID_SYNC(); DBG_STOP(9 + 8 * layer, ws + WS_H, (size_t)M * F * 2, ws, 0);
        for (int rep_ = 0; rep_ < NREP(15); ++rep_) { if (rep_) GRID_SYNC(); TIDS();
        if (PH(15)) { EpiRes E{X, X, modl + 5 * D}; GEMM(EpiRes, E, H, (const bf16_t*)(ws + WS_WDN) + (size_t)layer * D * F, M, D, F, 256, 64); }
        }
        GRID_SYNC(); DBG_STOP(10 + 8 * layer, ws, 0, ws, 0);
    }
    for (int rep_ = 0; rep_ < NREP(16); ++rep_) { if (rep_) GRID_SYNC(); TIDS();
    if (PH(16)) norm_phase(X, P.in[34], nullptr, 0, 0, nullptr, X, gw, NGW, lane);
    }
}
}

extern "C" void kernel_launch(void* const* d_in, const int* in_sizes, int n_in, void* d_out, int out_size, void* d_ws, size_t ws_size, hipStream_t stream) {
    static int grid = 0;
    if (grid == 0) {
        if (n_in != 35 || ws_size < mk::WS_END) { fprintf(stderr, "kernel_launch: unexpected inputs (n_in %d, ws %zu)\n", n_in, ws_size); grid = -1; return; }
        int dev = 0, cus = 0, per_cu = 0;
        if (hipGetDevice(&dev) != hipSuccess || hipDeviceGetAttribute(&cus, hipDeviceAttributeMultiprocessorCount, dev) != hipSuccess) { grid = -1; return; }
        if (hipFuncSetAttribute((const void*)mk::mega_fwd, hipFuncAttributeMaxDynamicSharedMemorySize, mk::LDS_BYTES) != hipSuccess) { fprintf(stderr, "kernel_launch: hipFuncSetAttribute failed\n"); grid = -1; return; }
        if (hipOccupancyMaxActiveBlocksPerMultiprocessor(&per_cu, (const void*)mk::mega_fwd, mk::NTHREADS, mk::LDS_BYTES) != hipSuccess || per_cu < 1) { fprintf(stderr, "kernel_launch: occupancy query says %d\n", per_cu); grid = -1; return; }
        grid = cus;
        if (grid != 256) { fprintf(stderr, "kernel_launch: built for a 256-CU device (got %d)\n", cus); grid = cus < 256 ? -1 : 256; if (grid < 0) return; }
    }
    if (grid < 0) return;
    mk::Ptrs p{};
    for (int i = 0; i < 35; ++i) p.in[i] = (const float*)d_in[i];
    p.out = (float*)d_out; p.ws = (unsigned char*)d_ws;
#ifdef EXP_MEMSET
    (void)hipMemsetAsync(d_ws, 0, mk::WS_END, stream); (void)hipMemsetAsync(d_out, 0, (size_t)out_size * 4, stream);
#endif
    (void)hipMemsetAsync((char*)d_ws + mk::WS_CTL, 0, 65536, stream);
    void* args[] = {&p};
    hipError_t e = hipLaunchCooperativeKernel((const void*)mk::mega_fwd, dim3(grid), dim3(mk::NTHREADS), args, mk::LDS_BYTES, stream);
    if (e != hipSuccess) fprintf(stderr, "cooperative launch failed: %s (grid %d)\n", hipGetErrorString(e), grid);
}
```
